# Optimizing an MI355X kernel written in HIP

```python
import math
import jax, jax.numpy as jnp
from jax import lax
import numpy as np

D_MODEL = 2048
BATCH = 1
SEQ = 8192
DEPTH = 4

HEAD_DIM = 128
N_HEADS_A = 8
N_HEADS_B = 8
Q_BLOCK = 128
MOBA_BLOCK = 256
MOBA_TOPK = 3
MOBA_Q_CHUNK = 64
N_BUCKETS = 32
MAX_DISTANCE = 128
MLA_HEADS = 16
MLA_Q_RANK = 512
MLA_KV_RANK = 512
MLA_NOPE = 128
MLA_ROPE = 64
MLA_V = 128
ROPE_THETA = 10000.0
D_FF = -(-8 * D_MODEL // (3 * 256)) * 256
DEEPNORM_ALPHA = (2 * DEPTH) ** 0.25
DEEPNORM_BETA = (8 * DEPTH) ** -0.25
N_EVEN = (DEPTH + 1) // 2
N_ODD = DEPTH // 2

DA = N_HEADS_A * HEAD_DIM
DB = N_HEADS_B * HEAD_DIM
AB_SPLITS = (DA, 2 * DA, 3 * DA, 3 * DA + N_HEADS_A,
             3 * DA + N_HEADS_A + DB, 3 * DA + N_HEADS_A + 2 * DB)
AB_IN = 3 * DA + N_HEADS_A + 3 * DB
AB_OUT = DA + DB
MLA_IN = MLA_Q_RANK + MLA_KV_RANK + MLA_ROPE

kernel_name = "fox_moba_mla_deepnorm_hybrid"


def layer_norm(x, g, b, eps=1e-5):
    xf = x.astype(jnp.float32)
    mu = jnp.mean(xf, axis=-1, keepdims=True)
    var = jnp.mean(jnp.square(xf - mu), axis=-1, keepdims=True)
    return ((xf - mu) * lax.rsqrt(var + eps)).astype(x.dtype) * g + b


def rms_norm(x, g, eps=1e-6):
    xf = x.astype(jnp.float32)
    return (xf * lax.rsqrt(jnp.mean(jnp.square(xf), axis=-1, keepdims=True) + eps)).astype(x.dtype) * g


def t5_bucket(rel):
    n = jnp.maximum(rel, 0)
    max_exact = N_BUCKETS // 2
    nf = jnp.maximum(n, 1).astype(jnp.float32)
    large = max_exact + (jnp.log(nf / max_exact) / math.log(MAX_DISTANCE / max_exact)
                         * (N_BUCKETS - max_exact)).astype(jnp.int32)
    large = jnp.minimum(large, N_BUCKETS - 1)
    return jnp.where(n < max_exact, n, large)


def rope_tables(S, dtype):
    inv = ROPE_THETA ** (-jnp.arange(0, MLA_ROPE, 2, dtype=jnp.float32) / MLA_ROPE)
    ang = jnp.arange(S, dtype=jnp.float32)[:, None] * inv[None, :]
    return jnp.cos(ang).astype(dtype), jnp.sin(ang).astype(dtype)


def apply_rope(x, cos, sin):
    x1, x2 = jnp.split(x, 2, axis=-1)
    c = cos[None, :, None, :]
    s = sin[None, :, None, :]
    return jnp.concatenate([x1 * c - x2 * s, x1 * s + x2 * c], axis=-1)


def causal_attention(q, k, v, log_decay=None):
    B, S, H, Dq = q.shape
    Dv = v.shape[-1]
    scale = Dq ** -0.5
    kpos = jnp.arange(S)
    cT = None if log_decay is None else jnp.cumsum(log_decay, axis=1).transpose(0, 2, 1)

    def block(i):
        start = i * Q_BLOCK
        qb = lax.dynamic_slice_in_dim(q, start, Q_BLOCK, axis=1)
        qpos = start + jnp.arange(Q_BLOCK)
        s = jnp.einsum('bqhd,bkhd->bhqk', qb, k, preferred_element_type=jnp.float32) * scale
        if cT is not None:
            cq = lax.dynamic_slice_in_dim(cT, start, Q_BLOCK, axis=2)
            s = s + (cq[..., :, None] - cT[..., None, :])
        s = jnp.where(qpos[:, None] >= kpos[None, :], s, -jnp.inf)
        p = jax.nn.softmax(s, axis=-1).astype(v.dtype)
        return jnp.einsum('bhqk,bkhd->bqhd', p, v)

    out = lax.map(block, jnp.arange(S // Q_BLOCK))
    return out.transpose(1, 0, 2, 3, 4).reshape(B, S, H, Dv)


def moba_attention(q, k, v, rel_bias):
    B, S, H, D = q.shape
    nb = -(-S // MOBA_BLOCK)
    pad = nb * MOBA_BLOCK - S
    kp = jnp.pad(k, ((0, 0), (0, pad), (0, 0), (0, 0)))
    vp = jnp.pad(v, ((0, 0), (0, pad), (0, 0), (0, 0)))
    kbt = kp.reshape(B, nb, MOBA_BLOCK, H, D).transpose(0, 3, 1, 2, 4)
    vbt = vp.reshape(B, nb, MOBA_BLOCK, H, D).transpose(0, 3, 1, 2, 4)
    k_mean = jnp.mean(kbt.astype(jnp.float32), axis=3)
    topk = min(MOBA_TOPK, nb)
    scale = D ** -0.5
    offs = jnp.arange(MOBA_BLOCK)
    bias_t = rel_bias.T.astype(jnp.float32)
    bi = jnp.arange(B)[:, None, None, None]
    hi = jnp.arange(H)[None, :, None, None]
    hi5 = jnp.arange(H)[None, :, None, None, None]

    def chunk(i):
        start = i * MOBA_Q_CHUNK
        qc = lax.dynamic_slice_in_dim(q, start, MOBA_Q_CHUNK, axis=1)
        qpos = start + jnp.arange(MOBA_Q_CHUNK)
        own = start // MOBA_BLOCK
        g = jnp.einsum('bqhd,bhnd->bhqn', qc.astype(jnp.float32), k_mean)
        g = jnp.where(jnp.arange(nb) < own, g, -jnp.inf)
        _, sel = lax.top_k(g, topk)
        valid = sel < own
        k_sel = kbt[bi, hi, sel]
        v_sel = vbt[bi, hi, sel]
        s_sel = jnp.einsum('bqhd,bhqnkd->bhqnk', qc, k_sel,
                           preferred_element_type=jnp.float32) * scale
        kpos_sel = sel[..., None] * MOBA_BLOCK + offs
        rel_sel = qpos[None, None, :, None, None] - kpos_sel
        s_sel = s_sel + bias_t[hi5, t5_bucket(rel_sel)]
        s_sel = jnp.where(valid[..., None], s_sel, -jnp.inf)
        k_own = lax.dynamic_slice_in_dim(kp, own * MOBA_BLOCK, MOBA_BLOCK, axis=1)
        v_own = lax.dynamic_slice_in_dim(vp, own * MOBA_BLOCK, MOBA_BLOCK, axis=1)
        rel_own = qpos[:, None] - (own * MOBA_BLOCK + offs)[None, :]
        s_own = jnp.einsum('bqhd,bkhd->bhqk', qc, k_own,
                           preferred_element_type=jnp.float32) * scale
        s_own = s_own + bias_t[:, t5_bucket(rel_own)][None]
        s_own = jnp.where(rel_own >= 0, s_own, -jnp.inf)
        s_all = jnp.concatenate(
            [s_sel.reshape(B, H, MOBA_Q_CHUNK, topk * MOBA_BLOCK), s_own], axis=-1)
        p = jax.nn.softmax(s_all, axis=-1).astype(v.dtype)
        p_sel = p[..., :topk * MOBA_BLOCK].reshape(B, H, MOBA_Q_CHUNK, topk, MOBA_BLOCK)
        p_own = p[..., topk * MOBA_BLOCK:]
        return (jnp.einsum('bhqnk,bhqnkd->bqhd', p_sel, v_sel)
                + jnp.einsum('bhqk,bkhd->bqhd', p_own, v_own))

    out = lax.map(chunk, jnp.arange(S // MOBA_Q_CHUNK))
    return out.transpose(1, 0, 2, 3, 4).reshape(B, S, H, D)


def fox_moba_mixer(x, w_in, b_f, w_out, rel_bias):
    B, S, _ = x.shape
    h = x @ w_in
    qa, ka, va, fa, qb, kb, vb = jnp.split(h, AB_SPLITS, axis=-1)
    shp_a = (B, S, N_HEADS_A, HEAD_DIM)
    shp_b = (B, S, N_HEADS_B, HEAD_DIM)
    log_f = jax.nn.log_sigmoid((fa + b_f).astype(jnp.float32))
    ya = causal_attention(qa.reshape(shp_a), ka.reshape(shp_a), va.reshape(shp_a), log_f)
    yb = moba_attention(qb.reshape(shp_b), kb.reshape(shp_b), vb.reshape(shp_b), rel_bias)
    y = jnp.concatenate([ya.reshape(B, S, DA), yb.reshape(B, S, DB)], axis=-1)
    return y @ w_out


def mla_mixer(x, w_in, q_norm_g, kv_norm_g, w_uq, w_ukv, w_out, cos, sin):
    B, S, _ = x.shape
    h = x @ w_in
    cq, ckv, k_rope = jnp.split(h, (MLA_Q_RANK, MLA_Q_RANK + MLA_KV_RANK), axis=-1)
    cq = rms_norm(cq, q_norm_g)
    ckv = rms_norm(ckv, kv_norm_g)
    q = (cq @ w_uq).reshape(B, S, MLA_HEADS, MLA_NOPE + MLA_ROPE)
    kv = (ckv @ w_ukv).reshape(B, S, MLA_HEADS, MLA_NOPE + MLA_V)
    q_nope, q_rope = jnp.split(q, (MLA_NOPE,), axis=-1)
    k_nope, v = jnp.split(kv, (MLA_NOPE,), axis=-1)
    q_rope = apply_rope(q_rope, cos, sin)
    k_rope = apply_rope(k_rope[:, :, None, :], cos, sin)
    q = jnp.concatenate([q_nope, q_rope], axis=-1)
    k = jnp.concatenate(
        [k_nope, jnp.broadcast_to(k_rope, (B, S, MLA_HEADS, MLA_ROPE))], axis=-1)
    y = causal_attention(q, k, v)
    return y.reshape(B, S, MLA_HEADS * MLA_V) @ w_out


def swiglu(x, w_gate, w_up, w_down):
    return (jax.nn.silu(x @ w_gate) * (x @ w_up)) @ w_down


def setup_inputs(seed: int = 0) -> dict:
    key = jax.random.key(seed)
    ks = jax.random.split(key, 16)
    f32 = jnp.float32

    def w(k, shape, fan_in, gain=1.0):
        return jax.random.normal(k, shape, f32) * (gain * fan_in ** -0.5)

    x = jax.random.normal(ks[0], (BATCH, SEQ, D_MODEL), f32)
    ab_w_in = w(ks[1], (N_EVEN, D_MODEL, AB_IN), D_MODEL)
    ab_forget_bias = 3.0 + 0.1 * jax.random.normal(ks[2], (N_EVEN, N_HEADS_A), f32)
    ab_w_out = w(ks[3], (N_EVEN, AB_OUT, D_MODEL), AB_OUT, DEEPNORM_BETA)
    rel_bias = 0.2 * jax.random.normal(ks[4], (N_BUCKETS, N_HEADS_B), f32)
    mla_w_in = w(ks[5], (N_ODD, D_MODEL, MLA_IN), D_MODEL)
    mla_q_norm = 1.0 + 0.02 * jax.random.normal(ks[6], (N_ODD, MLA_Q_RANK), f32)
    mla_kv_norm = 1.0 + 0.02 * jax.random.normal(ks[7], (N_ODD, MLA_KV_RANK), f32)
    mla_w_uq = w(ks[8], (N_ODD, MLA_Q_RANK, MLA_HEADS * (MLA_NOPE + MLA_ROPE)), MLA_Q_RANK)
    mla_w_ukv = w(ks[9], (N_ODD, MLA_KV_RANK, MLA_HEADS * (MLA_NOPE + MLA_V)), MLA_KV_RANK)
    mla_w_out = w(ks[10], (N_ODD, MLA_HEADS * MLA_V, D_MODEL), MLA_HEADS * MLA_V, DEEPNORM_BETA)
    ffn_w_gate = w(ks[11], (DEPTH, D_MODEL, D_FF), D_MODEL)
    ffn_w_up = w(ks[12], (DEPTH, D_MODEL, D_FF), D_MODEL)
    ffn_w_down = w(ks[13], (DEPTH, D_FF, D_MODEL), D_FF, DEEPNORM_BETA)
    ln_g = 1.0 + 0.02 * jax.random.normal(ks[14], (DEPTH, 2, D_MODEL), f32)
    ln_b = 0.02 * jax.random.normal(ks[15], (DEPTH, 2, D_MODEL), f32)
    return {"x": x, "ab_w_in": ab_w_in, "ab_forget_bias": ab_forget_bias,
            "ab_w_out": ab_w_out, "rel_bias": rel_bias, "mla_w_in": mla_w_in,
            "mla_q_norm": mla_q_norm, "mla_kv_norm": mla_kv_norm, "mla_w_uq": mla_w_uq,
            "mla_w_ukv": mla_w_ukv, "mla_w_out": mla_w_out, "ffn_w_gate": ffn_w_gate,
            "ffn_w_up": ffn_w_up, "ffn_w_down": ffn_w_down, "ln_g": ln_g, "ln_b": ln_b}


def reference(x, ab_w_in, ab_forget_bias, ab_w_out, rel_bias, mla_w_in, mla_q_norm,
              mla_kv_norm, mla_w_uq, mla_w_ukv, mla_w_out, ffn_w_gate, ffn_w_up,
              ffn_w_down, ln_g, ln_b):
    S = x.shape[1]
    cos, sin = rope_tables(S, x.dtype)
    for layer in range(DEPTH):
        j = layer // 2
        if layer % 2 == 0:
            y = fox_moba_mixer(x, ab_w_in[j], ab_forget_bias[j], ab_w_out[j], rel_bias)
        else:
            y = mla_mixer(x, mla_w_in[j], mla_q_norm[j], mla_kv_norm[j], mla_w_uq[j],
                          mla_w_ukv[j], mla_w_out[j], cos, sin)
        x = layer_norm(DEEPNORM_ALPHA * x + y, ln_g[layer, 0], ln_b[layer, 0])
        y = swiglu(x, ffn_w_gate[layer], ffn_w_up[layer], ffn_w_down[layer])
        x = layer_norm(DEEPNORM_ALPHA * x + y, ln_g[layer, 1], ln_b[layer, 1])
    return x
```

```cpp
#include <hip/hip_runtime.h>
#include <hip/hip_cooperative_groups.h>
#include <hip/hip_bf16.h>
#include <cstdio>
#include <cstdint>
#include <cmath>
namespace pg8 {
__device__ __forceinline__ int tid_opq() { int t = threadIdx.x; asm volatile("" : "+v"(t)); return t; }
#define PG8_LAS __attribute__((address_space(3)))
typedef unsigned short bf16_t;
typedef short bf16x8 __attribute__((ext_vector_type(8)));
typedef float f32x4 __attribute__((ext_vector_type(4)));
typedef unsigned u32x4 __attribute__((ext_vector_type(4)));
constexpr int BM = 256, BK = 64, HALF = 128, HTB = HALF * BK * 2  , STAGE_BYTES = 8 * HTB, NXCD = 8, WGM = 8;

__host__ __device__ __forceinline__ int lds_byte(int r, int c) { const int st = (r >> 4) * 2 + (c >> 5), rr = r & 15, cc = c & 31, ob = rr * 64 + cc * 2; return st * 1024 + (ob ^ (((ob >> 9) & 1) << 5)); }
__host__ __device__ __forceinline__ void stage_rc(int b, int& R, int& C) { const int st = b / 1024, sb = b % 1024, swz = sb ^ (((sb >> 9) & 1) << 5); R = (st >> 1) * 16 + swz / 64; C = (st & 1) * 32 + (swz % 64) / 2; }
__host__ __device__ __forceinline__ int perm32(int rho) { const int n = rho >> 4, i = rho & 15; return 8 * (i >> 2) + 4 * n + (i & 3); }

struct Unit { int pm, pn; };
struct Gemm { const bf16_t* A; const bf16_t* Bt; int M, N, K; };

struct StaticOrder {
    int nM, nN, nwg, G, c;
    __host__ __device__ void init(int M, int N, int G_, int c_) { nM = M / BM; nN = N / BM; nwg = nM * nN; G = G_; c = c_; }
    __host__ __device__ bool next(int i, Unit& u) const {
        const long L = (long)i * G + c; if (L >= nwg) return false;
        int wgid = (int)L; { const int q = nwg / NXCD, r = nwg % NXCD, xcd = wgid % NXCD, off = wgid / NXCD; wgid = (xcd < r ? xcd * (q + 1) : r * (q + 1) + (xcd - r) * q) + off; }
        const int nig = WGM * nN, gid = wgid / nig, fm = gid * WGM, gsz = (nM - fm) < WGM ? (nM - fm) : WGM;
        u.pm = fm + ((wgid % nig) % gsz); u.pn = (wgid % nig) / gsz; return true;
    }
    __device__ __forceinline__ void a_ready(const Unit&) const {}
    __device__ __forceinline__ void done(const Unit&) const {}
};

__device__ __forceinline__ unsigned cvt_pk_bf16(float lo, float hi) { unsigned r; asm volatile("v_cvt_pk_bf16_f32 %0, %1, %2" : "=v"(r) : "v"(lo), "v"(hi)); return r; }
typedef float f32x2 __attribute__((ext_vector_type(2)));
template <class Epi, class Sched, bool ALIGN_EPI = false, bool SP2 = false>
__device__ __forceinline__ void gemm_phase(PG8_LAS unsigned char* lds, const Gemm g, const Sched& S, const Epi& E) {
    const int tid = tid_opq(), wid = __builtin_amdgcn_readfirstlane(tid >> 6), lane = tid & 63, wr = wid >> 2, wc = wid & 3, fr = lane & 15, fq = lane >> 4;
    const int K = g.K, nt = K / BK;
    unsigned voffA[2], voffB[2];
#pragma unroll
    for (int i = 0; i < 2; ++i) { int R, C; stage_rc(tid * 16 + i * 8192, R, C); const int Rb = Epi::PERM ? ((R & ~31) + perm32(R & 31)) : R;
        voffA[i] = (unsigned)(R * K + C) * 2u; voffB[i] = (unsigned)(Rb * K + C) * 2u; }
    const size_t kstep = (size_t)(BK * 2);
    const size_t hstep = (size_t)HALF * K * 2;
    const size_t tstep = 2 * hstep;
    const unsigned ldsw = (unsigned)wid * 1024u;
    const int aoff = lds_byte(wr * 64 + fr, fq * 8), boff = lds_byte(wc * 32 + fr, fq * 8);
#define PG8_SA(b, h) (((b) * 2 + (h)) * HTB)
#define PG8_SB(b, h) ((4 + (b) * 2 + (h)) * HTB)
#define PG8_STAGE(bufoff, gbase, voff) do { _Pragma("unroll") for (int _i = 0; _i < 2; ++_i) \
        __builtin_amdgcn_global_load_lds((const unsigned*)((const char*)(gbase) + (voff)[_i]), (PG8_LAS unsigned*)(lds + (bufoff) + ldsw + _i * 8192), 16, 0, 0); } while (0)
#define PG8_LDA(dst, b, h) do { _Pragma("unroll") for (int m = 0; m < 4; ++m) _Pragma("unroll") for (int k = 0; k < 2; ++k) dst[m][k] = *(const PG8_LAS bf16x8*)(lds + PG8_SA(b, h) + aoff + m * 2048 + k * 1024); } while (0)
#define PG8_LDB(dst, b, h) do { _Pragma("unroll") for (int n = 0; n < 2; ++n) _Pragma("unroll") for (int k = 0; k < 2; ++k) dst[n][k] = *(const PG8_LAS bf16x8*)(lds + PG8_SB(b, h) + boff + n * 2048 + k * 1024); } while (0)
#define PG8_MMA(ai, bj, At, Bt) do { __builtin_amdgcn_s_setprio(1); _Pragma("unroll") for (int m = 0; m < 4; ++m) _Pragma("unroll") for (int n = 0; n < 2; ++n) _Pragma("unroll") for (int k = 0; k < 2; ++k) \
        acc[ai][bj][m][n] = __builtin_amdgcn_mfma_f32_16x16x32_bf16(Bt[n][k], At[m][k], acc[ai][bj][m][n], 0, 0, 0); __builtin_amdgcn_s_setprio(0); } while (0)
#define PG8_WAIT_V(n) asm volatile("s_waitcnt vmcnt(" #n ")" ::: "memory")
#define PG8_WAIT_L(n) asm volatile("s_waitcnt lgkmcnt(" #n ")" ::: "memory")
#define PG8_BAR __builtin_amdgcn_s_barrier()
#define PG8_SCHED __builtin_amdgcn_sched_barrier(0)
    Unit cur, nxt; int ui = 0;
    if (!S.next(0, cur)) return;
    f32x4 acc[2][2][4][2];
#pragma unroll
    for (int a = 0; a < 2; ++a)
#pragma unroll
        for (int b = 0; b < 2; ++b)
#pragma unroll
            for (int m = 0; m < 4; ++m)
#pragma unroll
                for (int n = 0; n < 2; ++n) acc[a][b][m][n] = (f32x4){0.f, 0.f, 0.f, 0.f};
    bf16x8 At[4][2], B0[2][2], B1[2][2];
    const char* cA = (const char*)g.A + (size_t)cur.pm * tstep; const char* cB = (const char*)g.Bt + (size_t)cur.pn * tstep;
    S.a_ready(cur);
    if constexpr (SP2) {
        PG8_STAGE(PG8_SB(0, 0), cB, voffB); PG8_STAGE(PG8_SB(0, 1), cB + hstep, voffB); PG8_STAGE(PG8_SA(0, 0), cA, voffA); PG8_STAGE(PG8_SA(0, 1), cA + hstep, voffA);
        if (wr == 1) PG8_BAR;
        PG8_WAIT_V(2); PG8_BAR;
        PG8_STAGE(PG8_SB(1, 0), cB + kstep, voffB); PG8_STAGE(PG8_SA(1, 0), cA + kstep, voffA); PG8_STAGE(PG8_SB(1, 1), cB + hstep + kstep, voffB);
        PG8_WAIT_V(6); PG8_BAR;
    } else {
        PG8_STAGE(PG8_SB(0, 0), cB, voffB); PG8_STAGE(PG8_SA(0, 0), cA, voffA); PG8_STAGE(PG8_SB(0, 1), cB + hstep, voffB); PG8_STAGE(PG8_SA(0, 1), cA + hstep, voffA);
        if (wr == 1) PG8_BAR;
        PG8_WAIT_V(4); PG8_BAR;
        PG8_STAGE(PG8_SB(1, 0), cB + kstep, voffB); PG8_STAGE(PG8_SA(1, 0), cA + kstep, voffA); PG8_STAGE(PG8_SB(1, 1), cB + hstep + kstep, voffB);
        PG8_WAIT_V(6); PG8_BAR;
    }
    for (;;) {
        const bool has_next = S.next(ui + 1, nxt);
        const char* nA = has_next ? (const char*)g.A + (size_t)nxt.pm * tstep : cA; const char* nB = has_next ? (const char*)g.Bt + (size_t)nxt.pn * tstep : cB;
        for (int t = 0; t < nt; t += 2) {
            const bool last = (t == nt - 2);
            const char* a1 = cA + (size_t)(t + 1) * kstep;
            const char* a2 = last ? nA : cA + (size_t)(t + 2) * kstep; const char* b2 = last ? nB : cB + (size_t)(t + 2) * kstep;
            const char* a3 = a2 + kstep; const char* b3 = b2 + kstep;
            if (last && has_next) S.a_ready(nxt);
            if constexpr (SP2) {
            PG8_LDB(B0, 0, 0); PG8_LDB(B1, 0, 1); PG8_SCHED; PG8_LDA(At, 0, 0); PG8_STAGE(PG8_SA(1, 1), a1 + hstep, voffA);
            PG8_WAIT_V(8); PG8_WAIT_L(0); PG8_BAR; PG8_MMA(0, 0, At, B0); PG8_MMA(0, 1, At, B1); PG8_BAR; PG8_SCHED;
            PG8_LDA(At, 0, 1); PG8_STAGE(PG8_SB(0, 0), b2, voffB); PG8_STAGE(PG8_SB(0, 1), b2 + hstep, voffB); PG8_STAGE(PG8_SA(0, 0), a2, voffA);
            PG8_WAIT_V(8); PG8_WAIT_L(0); PG8_BAR; PG8_MMA(1, 0, At, B0); PG8_MMA(1, 1, At, B1); PG8_BAR; PG8_SCHED;
            PG8_LDB(B0, 1, 0); PG8_LDB(B1, 1, 1); PG8_SCHED; PG8_LDA(At, 1, 0); PG8_STAGE(PG8_SA(0, 1), a2 + hstep, voffA);
            PG8_WAIT_V(8); PG8_WAIT_L(0); PG8_BAR; PG8_MMA(0, 0, At, B0); PG8_MMA(0, 1, At, B1); PG8_BAR; PG8_SCHED;
            PG8_LDA(At, 1, 1); PG8_STAGE(PG8_SB(1, 0), b3, voffB); PG8_STAGE(PG8_SB(1, 1), b3 + hstep, voffB); PG8_STAGE(PG8_SA(1, 0), a3, voffA);
            PG8_WAIT_V(8); PG8_WAIT_L(0); PG8_BAR; PG8_MMA(1, 0, At, B0); PG8_MMA(1, 1, At, B1); PG8_BAR; PG8_SCHED;
            } else {
            PG8_LDB(B0, 0, 0); PG8_SCHED; PG8_LDA(At, 0, 0); PG8_STAGE(PG8_SA(1, 1), a1 + hstep, voffA);
            PG8_WAIT_L(8); PG8_BAR; PG8_WAIT_L(0); PG8_MMA(0, 0, At, B0); PG8_BAR; PG8_SCHED;
            PG8_LDB(B1, 0, 1); PG8_STAGE(PG8_SB(0, 0), b2, voffB);
            PG8_BAR; PG8_WAIT_L(0); PG8_MMA(0, 1, At, B1); PG8_BAR;
            PG8_LDA(At, 0, 1); PG8_STAGE(PG8_SA(0, 0), a2, voffA);
            PG8_BAR; PG8_WAIT_L(0); PG8_MMA(1, 0, At, B0); PG8_BAR; PG8_SCHED;
            PG8_STAGE(PG8_SB(0, 1), b2 + hstep, voffB);
            PG8_WAIT_V(6); PG8_BAR; PG8_MMA(1, 1, At, B1); PG8_BAR;
            PG8_LDB(B0, 1, 0); PG8_SCHED; PG8_LDA(At, 1, 0); PG8_STAGE(PG8_SA(0, 1), a2 + hstep, voffA);
            PG8_WAIT_L(8); PG8_BAR; PG8_WAIT_L(0); PG8_MMA(0, 0, At, B0); PG8_BAR; PG8_SCHED;
            PG8_LDB(B1, 1, 1); PG8_STAGE(PG8_SB(1, 0), b3, voffB);
            PG8_BAR; PG8_WAIT_L(0); PG8_MMA(0, 1, At, B1); PG8_BAR;
            PG8_LDA(At, 1, 1); PG8_STAGE(PG8_SA(1, 0), a3, voffA);
            PG8_BAR; PG8_WAIT_L(0); PG8_MMA(1, 0, At, B0); PG8_BAR; PG8_SCHED;
            PG8_STAGE(PG8_SB(1, 1), b3 + hstep, voffB);
            PG8_WAIT_V(6); PG8_BAR; PG8_MMA(1, 1, At, B1); PG8_BAR;
            }
        }
        if constexpr (ALIGN_EPI) { if (wr == 0) PG8_BAR; }
        if constexpr (!Epi::AFTER_DRAIN) { E(acc, cur, wr, wc, fr, fq); S.done(cur); }
        if (!has_next) break;
#pragma unroll
        for (int a = 0; a < 2; ++a)
#pragma unroll
            for (int b = 0; b < 2; ++b)
#pragma unroll
                for (int m = 0; m < 4; ++m)
#pragma unroll
                    for (int n = 0; n < 2; ++n) acc[a][b][m][n] = (f32x4){0.f, 0.f, 0.f, 0.f};
        cur = nxt; cA = nA; cB = nB; ++ui;
        if constexpr (ALIGN_EPI) { if (wr == 1) PG8_BAR; }
    }
    PG8_WAIT_V(0);
    if constexpr (!ALIGN_EPI) { if (wr == 0) PG8_BAR; }
    PG8_BAR;
    if constexpr (Epi::AFTER_DRAIN) { E.fused(acc, cur, wr, wc, fr, fq, lds, wid, lane); S.done(cur); }
#undef PG8_SA
#undef PG8_SB
#undef PG8_STAGE
#undef PG8_LDA
#undef PG8_LDB
#undef PG8_MMA
#undef PG8_WAIT_V
#undef PG8_WAIT_L
#undef PG8_BAR
#undef PG8_SCHED
}
}
namespace pg8 {
typedef unsigned u32x2e __attribute__((ext_vector_type(2)));
constexpr int SEQ = 8192;
__device__ __forceinline__ u32x4 pack8bf(const f32x4 v0, const f32x4 v1) { u32x4 w; w.x = cvt_pk_bf16(v0[0], v0[1]); w.y = cvt_pk_bf16(v0[2], v0[3]); w.z = cvt_pk_bf16(v1[0], v1[1]); w.w = cvt_pk_bf16(v1[2], v1[3]); return w; }
struct EpiPlain {
    static constexpr bool PERM = true, AFTER_DRAIN = false;
    bf16_t* O; int ldc;
    __device__ __forceinline__ void operator()(const f32x4 (&acc)[2][2][4][2], const Unit& u, int wr, int wc, int fr, int fq) const {
        const int row0 = u.pm * BM + wr * 64 + fr, col0 = u.pn * BM + wc * 32 + 8 * fq;
#pragma unroll
        for (int ai = 0; ai < 2; ++ai)
#pragma unroll
            for (int m = 0; m < 4; ++m) { bf16_t* rowp = O + (size_t)(row0 + ai * HALF + m * 16) * ldc + col0;
#pragma unroll
                for (int bj = 0; bj < 2; ++bj) *(u32x4*)(rowp + bj * HALF) = pack8bf(acc[ai][bj][m][0], acc[ai][bj][m][1]); }
    }
};
struct EpiHeads {
    static constexpr bool PERM = true, AFTER_DRAIN = false;
    bf16_t* base; int tps, nh, ksec; float* kpart;
    __device__ __forceinline__ void operator()(const f32x4 (&acc)[2][2][4][2], const Unit& u, int wr, int wc, int fr, int fq) const {
        const int sec = u.pn / tps, h0 = (u.pn % tps) * 2, row0 = u.pm * BM + wr * 64 + fr, c0 = wc * 32 + 8 * fq;
#pragma unroll
        for (int bj = 0; bj < 2; ++bj) { bf16_t* hb = base + ((size_t)(sec * nh + h0 + bj) * SEQ) * 128 + c0;
#pragma unroll
            for (int ai = 0; ai < 2; ++ai)
#pragma unroll
                for (int m = 0; m < 4; ++m) *(u32x4*)(hb + (size_t)(row0 + ai * HALF + m * 16) * 128) = pack8bf(acc[ai][bj][m][0], acc[ai][bj][m][1]); }
        if (sec == ksec) {
#pragma unroll
            for (int bj = 0; bj < 2; ++bj)
#pragma unroll
                for (int n = 0; n < 2; ++n) { f32x4 s = (f32x4){0.f, 0.f, 0.f, 0.f};
#pragma unroll
                    for (int ai = 0; ai < 2; ++ai)
#pragma unroll
                        for (int m = 0; m < 4; ++m) s += acc[ai][bj][m][n];
#pragma unroll
                    for (int o = 1; o < 16; o <<= 1) { s[0] += __shfl_xor(s[0], o); s[1] += __shfl_xor(s[1], o); s[2] += __shfl_xor(s[2], o); s[3] += __shfl_xor(s[3], o); }
                    if (fr == 0) *(f32x4*)(kpart + ((size_t)((h0 + bj) * 32 + u.pm) * 2 + wr) * 128 + c0 + 4 * n) = s; }
        }
    }
};
struct EpiSwiglu {
    static constexpr bool PERM = true, AFTER_DRAIN = false;
    bf16_t* O; int ldc;
    __device__ __forceinline__ void operator()(const f32x4 (&acc)[2][2][4][2], const Unit& u, int wr, int wc, int fr, int fq) const {
        const int row0 = u.pm * BM + wr * 64 + fr, col0 = u.pn * HALF + wc * 32 + 8 * fq;
#pragma unroll
        for (int ai = 0; ai < 2; ++ai)
#pragma unroll
            for (int m = 0; m < 4; ++m) { f32x4 r[2];
#pragma unroll
                for (int n = 0; n < 2; ++n) { const f32x4 g = acc[ai][0][m][n], uu = acc[ai][1][m][n];
#pragma unroll
                    for (int j = 0; j < 4; ++j) r[n][j] = g[j] * __builtin_amdgcn_rcpf(1.f + __expf(-g[j])) * uu[j]; }
                *(u32x4*)(O + (size_t)(row0 + ai * HALF + m * 16) * ldc + col0) = pack8bf(r[0], r[1]); }
    }
};
struct EpiResid {
    static constexpr bool PERM = false, AFTER_DRAIN = false;
    const float* xres; float* z; float alpha;
    __device__ __forceinline__ void operator()(const f32x4 (&acc)[2][2][4][2], const Unit& u, int wr, int wc, int fr, int fq) const {
        const int row0 = u.pm * BM + wr * 64 + fr, col0 = u.pn * BM + wc * 32 + 4 * fq;
#pragma unroll
        for (int ai = 0; ai < 2; ++ai)
#pragma unroll
            for (int m = 0; m < 4; ++m) { const size_t off = (size_t)(row0 + ai * HALF + m * 16) * 2048 + col0;
#pragma unroll
                for (int bj = 0; bj < 2; ++bj)
#pragma unroll
                    for (int n = 0; n < 2; ++n) { const f32x4 xv = *(const f32x4*)(xres + off + bj * HALF + n * 16);
                        *(f32x4*)(z + off + bj * HALF + n * 16) = xv * alpha + acc[ai][bj][m][n]; } }
    }
};
struct EpiQup {
    static constexpr bool PERM = true, AFTER_DRAIN = false;
    bf16_t* QN; bf16_t* QR; const float* cosT; const float* sinT;
    __device__ __forceinline__ void operator()(const f32x4 (&acc)[2][2][4][2], const Unit& u, int wr, int wc, int fr, int fq) const {
        const int row0 = u.pm * BM + wr * 64 + fr;
        if (u.pn < 8) {
#pragma unroll
            for (int bj = 0; bj < 2; ++bj) { bf16_t* hb = QN + ((size_t)(u.pn * 2 + bj) * SEQ) * 128 + wc * 32 + 8 * fq;
#pragma unroll
                for (int ai = 0; ai < 2; ++ai)
#pragma unroll
                    for (int m = 0; m < 4; ++m) *(u32x4*)(hb + (size_t)(row0 + ai * HALF + m * 16) * 128) = pack8bf(acc[ai][bj][m][0], acc[ai][bj][m][1]); }
        } else {
            const int head = (u.pn - 8) * 4 + wc;
#pragma unroll
            for (int ai = 0; ai < 2; ++ai)
#pragma unroll
                for (int m = 0; m < 4; ++m) { const int row = row0 + ai * HALF + m * 16; f32x4 o1[2], o2[2];
#pragma unroll
                    for (int n = 0; n < 2; ++n) { const f32x4 c = *(const f32x4*)(cosT + (size_t)row * 32 + 8 * fq + 4 * n), s = *(const f32x4*)(sinT + (size_t)row * 32 + 8 * fq + 4 * n);
                        const f32x4 x1 = acc[ai][0][m][n], x2 = acc[ai][1][m][n]; o1[n] = x1 * c - x2 * s; o2[n] = x1 * s + x2 * c; }
                    bf16_t* dst = QR + ((size_t)head * SEQ + row) * 64 + 8 * fq;
                    *(u32x4*)dst = pack8bf(o1[0], o1[1]); *(u32x4*)(dst + 32) = pack8bf(o2[0], o2[1]); }
        }
    }
};
struct EpiKVup {
    static constexpr bool PERM = true, AFTER_DRAIN = false;
    bf16_t* KN; bf16_t* V;
    __device__ __forceinline__ void operator()(const f32x4 (&acc)[2][2][4][2], const Unit& u, int wr, int wc, int fr, int fq) const {
        const int row0 = u.pm * BM + wr * 64 + fr;
#pragma unroll
        for (int bj = 0; bj < 2; ++bj) { bf16_t* hb = (bj ? V : KN) + ((size_t)u.pn * SEQ) * 128 + wc * 32 + 8 * fq;
#pragma unroll
            for (int ai = 0; ai < 2; ++ai)
#pragma unroll
                for (int m = 0; m < 4; ++m) *(u32x4*)(hb + (size_t)(row0 + ai * HALF + m * 16) * 128) = pack8bf(acc[ai][bj][m][0], acc[ai][bj][m][1]); }
    }
};
}
namespace att {
using bf16 = __hip_bfloat16;
constexpr float THR = 8.f; constexpr int NW = 8, QBLK = 32, KVBLK = 64, QB = 256, D = 128; constexpr int SHM_V = KVBLK * D * 2, SHM_K = KVBLK * D * 2;
typedef short bf16x8 __attribute__((ext_vector_type(8)));
typedef short s16x4 __attribute__((ext_vector_type(4)));
typedef float f32x16 __attribute__((ext_vector_type(16)));
typedef float f32x4 __attribute__((ext_vector_type(4)));
typedef unsigned u32x4 __attribute__((ext_vector_type(4)));
template <class A, class Bt> struct same_t { static constexpr bool v = false; };
template <class A> struct same_t<A, A> { static constexpr bool v = true; };

#define KSWZ(row, colB) ((row) * 256 + ((colB) ^ (((row) & 7) << 4)))
#define SBAR() __builtin_amdgcn_sched_barrier(0)
__device__ __forceinline__ int v_st(int k, int c) { const int kk = (k & ~0xC) | ((k & 4) << 1) | ((k & 8) >> 1); return ((kk >> 3) * 4 + (c >> 5)) * 512 + ((kk & 7) * 32 + (c & 31)) * 2; }
__device__ __forceinline__ int v_rd_base(int lane) { return ((lane & 3) << 3) | (((lane >> 2) & 3) << 6) | (((lane >> 4) & 1) << 5) | (((lane >> 5) & 1) << 8); }
constexpr int v_rd_off(int d0, int ks, int half) { return d0 * 512 + ks * 4096 + half * 2048; }
__device__ __forceinline__ int crow(int r, int hi) { return (r & 3) + 8 * (r >> 2) + 4 * hi; }
__device__ __forceinline__ unsigned cvtpk(float lo, float hi) {
    unsigned r; asm volatile("v_cvt_pk_bf16_f32 %0, %1, %2" : "=v"(r) : "v"(lo), "v"(hi)); return r;
}
__device__ __forceinline__ bf16x8 pack8(f32x4 a, f32x4 b) {
    u32x4 w = {cvtpk(a[0], a[1]), cvtpk(a[2], a[3]), cvtpk(b[0], b[1]), cvtpk(b[2], b[3])};
    return *reinterpret_cast<bf16x8*>(&w);
}
template <class T> __device__ __forceinline__ bf16x8 load8(const T* p) {
    if constexpr (same_t<T, float>::v) { return pack8(*(const f32x4*)p, *(const f32x4*)(p + 4)); }
    else { return *reinterpret_cast<const bf16x8*>(p); }
}
__device__ __forceinline__ void mask_tile(f32x16& p0, f32x16& p1, int dq, unsigned W) {
    const float NEG = -__builtin_inff();
#pragma unroll
    for (int r = 0; r < 16; ++r) {
        const int c = (r & 3) + 8 * (r >> 2);
        if ((unsigned)(dq - c) >= W) p0[r] = NEG;
        if ((unsigned)(dq - c - 32) >= W) p1[r] = NEG;
    }
}
template <int MLA> __device__ __forceinline__ void partialSM(f32x16& p0, f32x16& p1, float& m_reg, float& mn, float& alpha) {
    constexpr float SCALE = MLA ? 0.07216878364870322f : 0.08838834764831845f;
    float pmax = p0[0]; for (int r = 1; r < 16; ++r) pmax = fmaxf(pmax, p0[r]); for (int r = 0; r < 16; ++r) pmax = fmaxf(pmax, p1[r]);
    { auto rr = __builtin_amdgcn_permlane32_swap(__float_as_uint(pmax), __float_as_uint(pmax), false, false);
      pmax = fmaxf(__uint_as_float(rr[0]), __uint_as_float(rr[1])); }
    constexpr float C2 = 1.4426950408889634f * SCALE;
    if (__builtin_expect(__all((pmax - m_reg) * SCALE <= THR), 1)) { mn = m_reg; alpha = 1.f; }
    else { mn = fmaxf(m_reg, pmax); alpha = __builtin_amdgcn_exp2f((m_reg - mn) * C2); m_reg = mn; }
    const float mnL = -mn * C2;
    for (int r = 0; r < 16; ++r) p0[r] = fmaf(p0[r], C2, mnL); for (int r = 0; r < 16; ++r) p1[r] = fmaf(p1[r], C2, mnL);
    for (int r = 0; r < 16; ++r) p0[r] = __builtin_amdgcn_exp2f(p0[r]);
}
__device__ __forceinline__ void finishSM(f32x16& p0, f32x16& p1, float alpha, float& l_reg, bf16x8& pa0, bf16x8& pa1, bf16x8& pa2, bf16x8& pa3) {
    for (int r = 0; r < 16; ++r) p1[r] = __builtin_amdgcn_exp2f(p1[r]);
    float ps = 0; for (int r = 0; r < 16; ++r) ps += p0[r]; for (int r = 0; r < 16; ++r) ps += p1[r];
    { auto rr = __builtin_amdgcn_permlane32_swap(__float_as_uint(ps), __float_as_uint(ps), false, false);
      ps = __uint_as_float(rr[0]) + __uint_as_float(rr[1]); }
    l_reg = l_reg * alpha + ps;
#define PK4(P, B_, OUT) do { unsigned a0 = cvtpk(P[B_+0], P[B_+1]), a1 = cvtpk(P[B_+2], P[B_+3]);                          \
        unsigned b0 = cvtpk(P[B_+4], P[B_+5]), b1 = cvtpk(P[B_+6], P[B_+7]);                                             \
        auto r0 = __builtin_amdgcn_permlane32_swap(a0, b0, false, false); auto r1 = __builtin_amdgcn_permlane32_swap(a1, b1, false, false); \
        u32x4 w = {r0[0], r1[0], r0[1], r1[1]}; OUT = *reinterpret_cast<bf16x8*>(&w); } while (0)
    PK4(p0, 0, pa0); PK4(p0, 8, pa1); PK4(p1, 0, pa2); PK4(p1, 8, pa3);
#undef PK4
}
template <int KB, bool SK>
__device__ __forceinline__ void qkt(f32x16& p0, f32x16& p1, const char* K_lds, int r32, int hi, const bf16x8* qr, bool act) {
    if (SK && !act) { const float NEG = -__builtin_inff();
#pragma unroll
        for (int r = 0; r < 16; ++r) { p0[r] = NEG; p1[r] = NEG; } return; }
    p0 = f32x16{}; p1 = f32x16{};
    const char* kb[4];
#pragma unroll
    for (int dd = 0; dd < 4; ++dd) kb[dd] = K_lds + KB * SHM_K + KSWZ(r32, (dd * 16 + hi * 8) * 2);
#pragma unroll
    for (int d0 = 0; d0 < 8; ++d0) { const char* a = kb[d0 & 3] + (d0 >> 2) * 128;
        bf16x8 b0 = *reinterpret_cast<const bf16x8*>(a);
        bf16x8 b1 = *reinterpret_cast<const bf16x8*>(a + 32 * 256);
        p0 = __builtin_amdgcn_mfma_f32_32x32x16_bf16(b0, qr[d0], p0, 0, 0, 0);
        p1 = __builtin_amdgcn_mfma_f32_32x32x16_bf16(b1, qr[d0], p1, 0, 0, 0); }
}
template <int VB, bool SK>
__device__ __forceinline__ void pv_tile(f32x16* o, int vb0, bf16x8 pa0, bf16x8 pa1, bf16x8 pa2, bf16x8 pa3, bool act) {
    if (SK && !act) return;
#define TRRD(dst, off) asm volatile("ds_read_b64_tr_b16 %0, %1 offset:%2" : "=&v"(dst) : "v"(vb0), "i"(off) : "memory")
#define PV_D0(d0) do { s16x4 l0, l1, l2, l3, h0, h1, h2, h3; constexpr int b_ = VB * SHM_V + v_rd_off(d0, 0, 0);     \
        TRRD(l0, b_); TRRD(h0, b_ + 2048); TRRD(l1, b_ + 4096); TRRD(h1, b_ + 6144); TRRD(l2, b_ + 8192); TRRD(h2, b_ + 10240); TRRD(l3, b_ + 12288); TRRD(h3, b_ + 14336); \
        asm volatile("s_waitcnt lgkmcnt(0)" ::: "memory"); SBAR();                 \
        o[d0] = __builtin_amdgcn_mfma_f32_32x32x16_bf16(pa0, (bf16x8){l0[0], l0[1], l0[2], l0[3], h0[0], h0[1], h0[2], h0[3]}, o[d0], 0, 0, 0);   \
        o[d0] = __builtin_amdgcn_mfma_f32_32x32x16_bf16(pa1, (bf16x8){l1[0], l1[1], l1[2], l1[3], h1[0], h1[1], h1[2], h1[3]}, o[d0], 0, 0, 0);   \
        o[d0] = __builtin_amdgcn_mfma_f32_32x32x16_bf16(pa2, (bf16x8){l2[0], l2[1], l2[2], l2[3], h2[0], h2[1], h2[2], h2[3]}, o[d0], 0, 0, 0);   \
        o[d0] = __builtin_amdgcn_mfma_f32_32x32x16_bf16(pa3, (bf16x8){l3[0], l3[1], l3[2], l3[3], h3[0], h3[1], h3[2], h3[3]}, o[d0], 0, 0, 0); } while (0)
    PV_D0(0); PV_D0(1); PV_D0(2); PV_D0(3);
#undef PV_D0
#undef TRRD
}
struct Ref { const bf16* Q; const bf16* K; const bf16* V; const bf16* Q2; bf16* O; int P0; const unsigned* selb; };
struct Ctx { const bf16* K2; const float* cks; const float* tab; float b31; };
struct Seam { bf16x8 qr[4]; bf16x8 st_v0, st_v1, st_k0, st_k1, st_r; };
constexpr int OST = 2048;
constexpr int SHM_R = 64 * 64 * 2;
constexpr int LDS_R = 2 * SHM_V + 2 * SHM_K + NW * 64 * 4;
constexpr int LDS_X = LDS_R + 2 * SHM_R;
constexpr int LDS_TAB = LDS_X + 32768;
constexpr int LDS_SEL = LDS_TAB + 1024;
constexpr int LDS_QH = LDS_SEL + 2048;
constexpr int LDS_ATT_END = LDS_QH + 32768;
#define RSWZ(row, chunk) ((row) * 128 + ((((chunk) ^ ((row) >> 1)) & 7) << 4))
template <int KB>
__device__ __forceinline__ void qkt_rope(f32x16& p0, f32x16& p1, const char* R_lds, int r32, int hi, const char* q2l) {
#pragma unroll
    for (int d0 = 0; d0 < 4; ++d0) { const char* a = R_lds + KB * SHM_R + RSWZ(r32, d0 * 2 + hi);
        bf16x8 b0 = *reinterpret_cast<const bf16x8*>(a);
        bf16x8 b1 = *reinterpret_cast<const bf16x8*>(a + 32 * 128);
        const bf16x8 qf = *reinterpret_cast<const bf16x8*>(q2l + d0 * 1024);
        p0 = __builtin_amdgcn_mfma_f32_32x32x16_bf16(b0, qf, p0, 0, 0, 0);
        p1 = __builtin_amdgcn_mfma_f32_32x32x16_bf16(b1, qf, p1, 0, 0, 0); }
}
template <int KB>
__device__ __forceinline__ void qkt_mix(f32x16& p0, f32x16& p1, const char* K_lds, int r32, int hi, const bf16x8* qr, const char* qhl) {
    p0 = f32x16{}; p1 = f32x16{};
    const char* kb[4];
#pragma unroll
    for (int dd = 0; dd < 4; ++dd) kb[dd] = K_lds + KB * SHM_K + KSWZ(r32, (dd * 16 + hi * 8) * 2);
#pragma unroll
    for (int d0 = 0; d0 < 8; ++d0) { const char* a = kb[d0 & 3] + (d0 >> 2) * 128;
        bf16x8 b0 = *reinterpret_cast<const bf16x8*>(a);
        bf16x8 b1 = *reinterpret_cast<const bf16x8*>(a + 32 * 256);
        bf16x8 qf; if (d0 < 4) qf = qr[d0]; else qf = *reinterpret_cast<const bf16x8*>(qhl + (d0 - 4) * 1024);
        p0 = __builtin_amdgcn_mfma_f32_32x32x16_bf16(b0, qf, p0, 0, 0, 0);
        p1 = __builtin_amdgcn_mfma_f32_32x32x16_bf16(b1, qf, p1, 0, 0, 0); }
}
template <int MODE>
__device__ __forceinline__ void bias_tile(f32x16& p0, f32x16& p1, const Ctx& C, int kb, int qlo, int r32, int hi, float cqs, unsigned selbits) {
    if constexpr (MODE == 0) {
        const float* ck = C.cks + kb + 4 * hi;
#pragma unroll
        for (int j = 0; j < 4; ++j) { const f32x4 a = *(const f32x4*)(ck + 8 * j), b = *(const f32x4*)(ck + 32 + 8 * j);
#pragma unroll
            for (int i = 0; i < 4; ++i) { p0[4 * j + i] += cqs - a[i]; p1[4 * j + i] += cqs - b[i]; } }
    } else if constexpr (MODE == 1) {
        const bool sel = (selbits >> (kb >> 8)) & 1u;
        if (qlo - (kb + 63) >= 128) {
            const float bb = C.b31;
#pragma unroll
            for (int r = 0; r < 16; ++r) { p0[r] += bb; p1[r] += bb; }
        } else {
            const int dq = qlo + r32 - kb - 4 * hi;
#pragma unroll
            for (int r = 0; r < 16; ++r) { const int c = (r & 3) + 8 * (r >> 2);
                int r0 = dq - c, r1 = dq - c - 32; r0 = r0 < 0 ? 0 : (r0 > 128 ? 128 : r0); r1 = r1 < 0 ? 0 : (r1 > 128 ? 128 : r1);
                p0[r] += C.tab[r0]; p1[r] += C.tab[r1]; }
        }
        if (!sel) { const float NEG = -__builtin_inff();
#pragma unroll
            for (int r = 0; r < 16; ++r) { p0[r] = NEG; p1[r] = NEG; } }
    }
}
#define ROW(p, k0, rr) ((p) + (size_t)((k0) + (rr)) * D + sc)
#define VMW() asm volatile("s_waitcnt vmcnt(0)" ::: "memory")
#define VMWN(n) asm volatile("s_waitcnt vmcnt(%0)" :: "i"(n) : "memory")
#define RLOAD(k0) do { if constexpr (MODE == 2) S.st_r = *reinterpret_cast<const bf16x8*>(C.K2 + (size_t)((k0) + (tid >> 3)) * 64 + (tid & 7) * 8); } while (0)
#define SLOAD_H(Kp, Vp, k0) do { S.st_v0 = load8<bf16>(ROW(Vp, k0, sr)); S.st_v1 = load8<bf16>(ROW(Vp, k0, 32 + sr));              \
                         S.st_k0 = load8<bf16>(ROW(Kp, k0, sr)); S.st_k1 = load8<bf16>(ROW(Kp, k0, 32 + sr)); RLOAD(k0); } while (0)
#define SWRITE_HK(bf) do { *(bf16x8*)(K_lds + (bf) * SHM_K + kws) = S.st_k0; *(bf16x8*)(K_lds + (bf) * SHM_K + kws + 32 * 256) = S.st_k1; \
                           if constexpr (MODE == 2) *(bf16x8*)(R_lds + (bf) * SHM_R + rws) = S.st_r; } while (0)
#define SWRITE_HV(bf) do { *(bf16x8*)(V_lds + (bf) * SHM_V + vst0) = S.st_v0; *(bf16x8*)(V_lds + (bf) * SHM_V + vst1) = S.st_v1; } while (0)
#define SWRITE_H(bf) do { SWRITE_HV(bf); SWRITE_HK(bf); } while (0)
template <int MODE>
__device__ __forceinline__ void att_prime(const Ref& cur, const Ctx& C, char* lds, Seam& S) {
    const int tid = pg8::tid_opq(), wid = __builtin_amdgcn_readfirstlane(tid >> 6), lane = tid & 63, r32 = lane & 31, hi = lane >> 5;
    const int sr = tid >> 4, sc = (tid & 15) * 8, kws = KSWZ(sr, sc * 2), rws = RSWZ(tid >> 3, tid & 7); char* K_lds = lds + 2 * SHM_V; char* R_lds = lds + LDS_R;
#pragma unroll
    for (int d0 = 0; d0 < 4; ++d0) S.qr[d0] = load8<bf16>(cur.Q + (size_t)(wid * QBLK + r32) * D + d0 * 16 + hi * 8);
    SLOAD_H(cur.K, cur.V, 0); VMW(); SWRITE_HK(0);
    __syncthreads();
}
template <int MODE>
__device__ __forceinline__ void att_block(const Ref& cur, const Ref& nxt, const Ctx& C, char* lds, Seam& S) {
    constexpr int MLA = (MODE == 2) ? 1 : 0;
    constexpr bool SK = false;
    constexpr int W = 0x7fffffff;
    const int tid = pg8::tid_opq(), wid = __builtin_amdgcn_readfirstlane(tid >> 6), lane = tid & 63, r32 = lane & 31, hi = lane >> 5;
    const int NT = cur.P0 / KVBLK + 4;
    const int qlo = cur.P0 + wid * QBLK, qm = qlo + r32 - 4 * hi;
    char* V_lds = lds; char* K_lds = lds + 2 * SHM_V; char* R_lds = lds + LDS_R;
    float* ws = (float*)(lds + 2 * SHM_V + 2 * SHM_K) + wid * 64; float* li_l = ws, * al_l = ws + 32;
    float m_reg = -1e30f, l_reg = 0; f32x16 o[4] = {};
    const int sr = tid >> 4, sc = (tid & 15) * 8, vst0 = v_st(sr, sc), vst1 = v_st(32 + sr, sc), kws = KSWZ(sr, sc * 2), rws = RSWZ(tid >> 3, tid & 7);
    const int vb0 = (int)(uintptr_t)V_lds + v_rd_base(lane);
    const bf16* Kh = cur.K; const bf16* Vh = cur.V;
    float cqs = 0.f; unsigned selbits = 0u;
    if constexpr (MODE == 0) cqs = C.cks[qlo + r32];
    if constexpr (MODE == 1) selbits = cur.selb[wid * QBLK + r32];
#define RESC(a) do { if (__any((a) < 1.f)) { if (hi == 0) al_l[r32] = (a); asm volatile("s_waitcnt lgkmcnt(0)" ::: "memory");              \
                     for (int d_ = 0; d_ < 4; ++d_) for (int r = 0; r < 16; ++r) o[d_][r] *= al_l[crow(r, hi)]; } } while (0)
#define KBASE(t) ((t) * KVBLK)
#define MASKT(P0_, P1_, t) do { const int kb_ = KBASE(t); bias_tile<MODE>(P0_, P1_, C, kb_, qlo, r32, hi, cqs, selbits); if (kb_ + KVBLK - 1 > qlo) mask_tile(P0_, P1_, qm - kb_, (unsigned)W); } while (0)
#define QKT(KB, PX0, PX1) do { qkt_mix<KB>(PX0, PX1, K_lds, r32, hi, S.qr, qhl); if constexpr (MODE == 2) qkt_rope<KB>(PX0, PX1, R_lds, r32, hi, q2l); } while (0)
    constexpr int NQL = 4;
#define SEAM_K0() do { VMWN(NQL); SWRITE_HK(0); SBAR(); } while (0)
    f32x16 pA0, pA1, pB0, pB1; float mnA, mnB, alA, alB; bf16x8 pa0, pa1, pa2, pa3;
    char* q2l = lds + LDS_X + wid * 4096 + lane * 16;
    char* qhl = lds + LDS_QH + wid * 4096 + lane * 16;
#pragma unroll
    for (int d0 = 4; d0 < 8; ++d0) *(bf16x8*)(qhl + (d0 - 4) * 1024) = load8<bf16>(cur.Q + (size_t)(wid * QBLK + r32) * D + d0 * 16 + hi * 8);
    if constexpr (MODE == 2) {
#pragma unroll
        for (int d0 = 0; d0 < 4; ++d0) *(bf16x8*)(q2l + d0 * 1024) = load8<bf16>(cur.Q2 + (size_t)(wid * QBLK + r32) * 64 + d0 * 16 + hi * 8); }
    SWRITE_HV(0); SBAR();
    if (NT > 1) { SLOAD_H(Kh, Vh, KBASE(1)); }
    SBAR(); QKT(0, pA0, pA1);
    MASKT(pA0, pA1, 0); partialSM<MLA>(pA0, pA1, m_reg, mnA, alA);
    if (NT > 1) { VMW(); SWRITE_H(1); }
    __syncthreads();
#define HALF_STEP(PX0, PX1, mnX, alX, PY0, PY1, alY, t, KB, VB, SB) do {                                                      \
        SBAR(); QKT(KB, PX0, PX1);                                                                                            \
        finishSM(PY0, PY1, alY, l_reg, pa0, pa1, pa2, pa3); SBAR();                                                           \
        if ((t) + 1 < NT) { SLOAD_H(Kh, Vh, KBASE((t) + 1)); SBAR(); }                                                        \
        pv_tile<VB, SK>(o, vb0, pa0, pa1, pa2, pa3, true); MASKT(PX0, PX1, (t)); partialSM<MLA>(PX0, PX1, m_reg, mnX, alX);   \
        __syncthreads();                                                                                                      \
        if ((t) + 1 < NT) { VMW(); SWRITE_H(SB); }                                                                            \
        RESC(alX); __syncthreads(); } while (0)
    for (int t = 1; t + 1 < NT; t += 2) {
        HALF_STEP(pB0, pB1, mnB, alB, pA0, pA1, alA, t, 1, 0, 0);
        HALF_STEP(pA0, pA1, mnA, alA, pB0, pB1, alB, t + 1, 0, 1, 1);
    }
    const bool even = (NT & 1) == 0;
    if (even) { SBAR(); QKT(1, pB0, pB1); SBAR(); }
    { SLOAD_H(nxt.K, nxt.V, 0); SBAR();
#pragma unroll
      for (int d0 = 0; d0 < 4; ++d0) S.qr[d0] = load8<bf16>(nxt.Q + (size_t)(wid * QBLK + r32) * D + d0 * 16 + hi * 8);
    }
    SBAR();
    finishSM(pA0, pA1, alA, l_reg, pa0, pa1, pa2, pa3); SBAR();
    pv_tile<0, SK>(o, vb0, pa0, pa1, pa2, pa3, true);
    if (even) { MASKT(pB0, pB1, NT - 1); partialSM<MLA>(pB0, pB1, m_reg, mnB, alB); __syncthreads(); RESC(alB);
        finishSM(pB0, pB1, alB, l_reg, pa0, pa1, pa2, pa3); SBAR(); pv_tile<1, SK>(o, vb0, pa0, pa1, pa2, pa3, true); }
    SBAR(); SEAM_K0();
    if (hi == 0) li_l[r32] = l_reg; asm volatile("s_waitcnt lgkmcnt(0)" ::: "memory");
    float rli[16];
#pragma unroll
    for (int r = 0; r < 16; ++r) rli[r] = __builtin_amdgcn_rcpf(li_l[crow(r, hi)]);
    bf16* Ow = cur.O + (size_t)(wid * QBLK) * OST;
#pragma unroll
    for (int r = 0; r < 16; ++r) { const int orow = crow(r, hi);
#pragma unroll
        for (int d0 = 0; d0 < 4; ++d0) { const float v = o[d0][r] * rli[r];
            const float vn = __shfl_xor(v, 1);
            if ((r32 & 1) == 0) *(unsigned*)(Ow + (size_t)orow * OST + d0 * 32 + r32) = cvtpk(v, vn); } }
    __syncthreads();
#undef RESC
#undef KBASE
#undef MASKT
#undef QKT
#undef SEAM_K0
#undef HALF_STEP
}
#undef ROW
#undef VMW
#undef VMWN
#undef RLOAD
#undef SLOAD_H
#undef SWRITE_HK
#undef SWRITE_HV
#undef SWRITE_H
#undef SBAR
#undef KSWZ
}
namespace cg = cooperative_groups;
#define LAS __attribute__((address_space(3)))
typedef unsigned short bf16r;
typedef unsigned v4u __attribute__((ext_vector_type(4)));
typedef float f32x4 __attribute__((ext_vector_type(4)));
constexpr int S_ = 8192, DM = 2048, DFF = 5632, NGU = 11264, ABIN = 6152, MLAIN = 1088, MLAINP = 1280;
constexpr float ALPHA = 1.681792830507429f;
constexpr float LN_EPS = 1e-5f, RMS_EPS = 1e-6f;
constexpr int LDS_BYTES = 155648;
constexpr size_t MiB = 1u << 20;
constexpr size_t E_WIN_E = (size_t)6144 * 2048, E_W2K = (size_t)2048 * 2048, E_WIN_O = (size_t)MLAINP * 2048, E_WUQ = (size_t)3072 * 512, E_WUKV = (size_t)4096 * 512,
                 E_WGU = (size_t)NGU * 2048, E_WDN = (size_t)2048 * DFF;
constexpr size_t O_WIN_E = 0, O_WOUT_E = O_WIN_E + 2 * E_WIN_E, O_WIN_O = O_WOUT_E + 2 * E_W2K, O_WUQ = O_WIN_O + 2 * E_WIN_O, O_WUKV = O_WUQ + 2 * E_WUQ,
                 O_WOUT_O = O_WUKV + 2 * E_WUKV, O_WGU = O_WOUT_O + 2 * E_W2K, O_WDN = O_WGU + 4 * E_WGU, O_WEND = O_WDN + 4 * E_WDN;
constexpr size_t WS_W = 0;
constexpr size_t WS_XF = ((O_WEND * 2 + MiB - 1) / MiB) * MiB;
constexpr size_t WS_XB = WS_XF + 64 * MiB;
constexpr size_t WS_Z = WS_XB + 32 * MiB;
constexpr size_t WS_AO = WS_Z + 64 * MiB;
constexpr size_t WS_ACT = WS_AO + 32 * MiB;
constexpr size_t WS_SMALL = WS_ACT + 160 * MiB;
constexpr size_t WS_COS = WS_SMALL, WS_SIN = WS_COS + 1 * MiB, WS_LOGF = WS_SIN + 1 * MiB, WS_KPART = WS_LOGF + 1 * MiB, WS_END = WS_KPART + 1 * MiB;
constexpr size_t A_HM = 0, A_CQN = 20 * MiB, A_CKVN = 28 * MiB, A_KR = 36 * MiB, A_QN = 40 * MiB, A_QR = 72 * MiB, A_KN = 88 * MiB, A_V = 120 * MiB;

struct Args { const float* in[16]; float* out; unsigned char* ws; int ph_lo, ph_hi; };

__device__ __forceinline__ unsigned f2bf(float f) { unsigned u = __builtin_bit_cast(unsigned, f); return (u + 0x7fffu + ((u >> 16) & 1u)) >> 16; }
__device__ __forceinline__ unsigned pk2(float lo, float hi) { return f2bf(lo) | (f2bf(hi) << 16); }
__device__ __forceinline__ float bf2f(unsigned short b) { return __builtin_bit_cast(float, (unsigned)b << 16); }
__device__ __forceinline__ float wave_sum(float v) {
#pragma unroll
    for (int o = 1; o < 64; o <<= 1) v += __shfl_xor(v, o);
    return v;
}
#define LDS_WAIT() asm volatile("s_waitcnt lgkmcnt(0)" ::: "memory")

__device__ __forceinline__ int map_row(int mode, int n) {
    switch (mode) {
        case 1: return n < 3072 ? n : (n < 3080 ? -1 : n - 8);
        case 2: { const int h = n / 192, d = n % 192; if (d < 128) return h * 128 + d; const int r = d - 128; return 2048 + (h >> 2) * 256 + (r >> 5) * 128 + (h & 3) * 32 + (r & 31); }
        case 3: return (n >> 7) * 256 + (n & 127);
        case 4: return (n >> 7) * 256 + 128 + (n & 127);
        default: return n;
    }
}
__device__ __forceinline__ void transpose_item(const float* W, int K, int N, bf16r* WT, int mode, LAS float* scr, int item, int lane) {
    const int nblk = (N + 31) >> 5, kb = item / nblk, nb = item - kb * nblk, k0 = 64 * kb, n0 = 32 * nb;
    const int nn = n0 + (lane & 31); const bool okn = nn < N;
#pragma unroll 8
    for (int i = 0; i < 32; ++i) { const int kk = 2 * i + (lane >> 5); scr[kk * 33 + (lane & 31)] = okn ? W[(size_t)(k0 + kk) * N + nn] : 0.f; }
    LDS_WAIT(); asm volatile("" ::: "memory");
    const int c = lane & 7;
#pragma unroll
    for (int j = 0; j < 4; ++j) { const int n = (lane >> 3) + 8 * j; const LAS float* s = scr + (8 * c) * 33 + n;
        v4u o; o.x = pk2(s[0 * 33], s[1 * 33]); o.y = pk2(s[2 * 33], s[3 * 33]); o.z = pk2(s[4 * 33], s[5 * 33]); o.w = pk2(s[6 * 33], s[7 * 33]);
        const int gn = n0 + n; const int dr = gn < N ? map_row(mode, gn) : -1;
        if (dr >= 0) *(v4u*)(WT + (size_t)dr * K + k0 + 8 * c) = o; }
    LDS_WAIT(); asm volatile("" ::: "memory");
}
struct WDesc { int in_idx; unsigned src_off; int K, N, mode; unsigned dst_off; int nitems; };
#define WD(ii, so, K_, N_, md, dof) { ii, (unsigned)(so), K_, N_, md, (unsigned)(dof), ((K_) / 64) * (((N_) + 31) / 32) }
__constant__ WDesc g_wdesc[24] = {
    WD(1, 0, 2048, ABIN, 1, O_WIN_E), WD(1, (size_t)2048 * ABIN, 2048, ABIN, 1, O_WIN_E + E_WIN_E),
    WD(3, 0, 2048, 2048, 0, O_WOUT_E), WD(3, E_W2K, 2048, 2048, 0, O_WOUT_E + E_W2K),
    WD(5, 0, 2048, MLAIN, 0, O_WIN_O), WD(5, (size_t)2048 * MLAIN, 2048, MLAIN, 0, O_WIN_O + E_WIN_O),
    WD(8, 0, 512, 3072, 2, O_WUQ), WD(8, E_WUQ, 512, 3072, 2, O_WUQ + E_WUQ),
    WD(9, 0, 512, 4096, 0, O_WUKV), WD(9, E_WUKV, 512, 4096, 0, O_WUKV + E_WUKV),
    WD(10, 0, 2048, 2048, 0, O_WOUT_O), WD(10, E_W2K, 2048, 2048, 0, O_WOUT_O + E_W2K),
    WD(11, 0, 2048, DFF, 3, O_WGU), WD(11, (size_t)2048 * DFF, 2048, DFF, 3, O_WGU + E_WGU), WD(11, (size_t)2 * 2048 * DFF, 2048, DFF, 3, O_WGU + 2 * E_WGU), WD(11, (size_t)3 * 2048 * DFF, 2048, DFF, 3, O_WGU + 3 * E_WGU),
    WD(12, 0, 2048, DFF, 4, O_WGU), WD(12, (size_t)2048 * DFF, 2048, DFF, 4, O_WGU + E_WGU), WD(12, (size_t)2 * 2048 * DFF, 2048, DFF, 4, O_WGU + 2 * E_WGU), WD(12, (size_t)3 * 2048 * DFF, 2048, DFF, 4, O_WGU + 3 * E_WGU),
    WD(13, 0, DFF, 2048, 0, O_WDN), WD(13, E_WDN, DFF, 2048, 0, O_WDN + E_WDN), WD(13, 2 * E_WDN, DFF, 2048, 0, O_WDN + 2 * E_WDN), WD(13, 3 * E_WDN, DFF, 2048, 0, O_WDN + 3 * E_WDN)
};
#undef WD

__device__ __forceinline__ void load_wfT(LAS float* wfT, const float* Win  ) {
    for (int idx = pg8::tid_opq(); idx < 16384; idx += 512) { const int k = idx >> 3, h = idx & 7; wfT[h * 2048 + k] = Win[(size_t)k * ABIN + 3072 + h]; }
    __syncthreads();
}
__device__ __forceinline__ void row_phase(int gw, int NGW, int lane, const float* src, bool do_ln, const float* g, const float* b, float* dst_f, bf16r* dst_b,
                                          const LAS float* wfT, const float* fbias, float* logf) {
    for (int m = gw; m < S_; m += NGW) {
        const f32x4* xr = (const f32x4*)(src + (size_t)m * DM) + lane;
        f32x4 v[8];
#pragma unroll
        for (int j = 0; j < 8; ++j) v[j] = xr[64 * j];
        if (do_ln) {
            float s = 0.f;
#pragma unroll
            for (int j = 0; j < 8; ++j) s += (v[j].x + v[j].y) + (v[j].z + v[j].w);
            const float mean = wave_sum(s) * (1.f / DM); float s2 = 0.f;
#pragma unroll
            for (int j = 0; j < 8; ++j) { v[j] = v[j] - mean; s2 += (v[j].x * v[j].x + v[j].y * v[j].y) + (v[j].z * v[j].z + v[j].w * v[j].w); }
            const float rstd = 1.f / sqrtf(wave_sum(s2) * (1.f / DM) + LN_EPS);
#pragma unroll
            for (int j = 0; j < 8; ++j) { const f32x4 gg = *((const f32x4*)g + lane + 64 * j), bb = *((const f32x4*)b + lane + 64 * j); v[j] = v[j] * rstd * gg + bb; }
        }
        if (dst_f) { f32x4* o = (f32x4*)(dst_f + (size_t)m * DM) + lane;
#pragma unroll
            for (int j = 0; j < 8; ++j) o[64 * j] = v[j]; }
        if (dst_b) { unsigned long long* o8 = (unsigned long long*)(dst_b + (size_t)m * DM) + lane;
#pragma unroll
            for (int j = 0; j < 8; ++j) o8[64 * j] = (unsigned long long)pk2(v[j].x, v[j].y) | ((unsigned long long)pk2(v[j].z, v[j].w) << 32); }
        if (logf) {
            float mine = 0.f;
#pragma unroll 1
            for (int h = 0; h < 8; ++h) { float a = 0.f;
#pragma unroll
                for (int j = 0; j < 8; ++j) { const f32x4 w = *((const LAS f32x4*)(wfT + h * 2048) + lane + 64 * j); a += (v[j].x * w.x + v[j].y * w.y) + (v[j].z * w.z + v[j].w * w.w); }
                a = wave_sum(a); if (lane == h) mine = a; }
            if (lane < 8) { const float zf = mine + fbias[lane];
                logf[(size_t)lane * S_ + m] = fminf(zf, 0.f) - log1pf(__expf(-fabsf(zf))); }
        }
    }
}
__device__ __forceinline__ void mla_row_phase(int gw, int NGW, int lane, const bf16r* HM, const float* gq, const float* gkv, const float* cosT, const float* sinT,
                                              bf16r* CQN, bf16r* CKVN, bf16r* KR) {
    float gqv[8], gkvv[8];
#pragma unroll
    for (int e = 0; e < 8; ++e) { gqv[e] = gq[8 * lane + e]; gkvv[e] = gkv[8 * lane + e]; }
    for (int m = gw; m < S_; m += NGW) {
        const bf16r* row = HM + (size_t)m * MLAINP;
        const v4u a = *((const v4u*)row + lane), c = *((const v4u*)(row + 512) + lane);
        float xa[8], xc[8];
#pragma unroll
        for (int e = 0; e < 4; ++e) { xa[2 * e] = __builtin_bit_cast(float, a[e] << 16); xa[2 * e + 1] = __builtin_bit_cast(float, a[e] & 0xffff0000u);
                                      xc[2 * e] = __builtin_bit_cast(float, c[e] << 16); xc[2 * e + 1] = __builtin_bit_cast(float, c[e] & 0xffff0000u); }
        float sa = 0.f, sc2 = 0.f;
#pragma unroll
        for (int e = 0; e < 8; ++e) { sa += xa[e] * xa[e]; sc2 += xc[e] * xc[e]; }
        const float ra = 1.f / sqrtf(wave_sum(sa) * (1.f / 512.f) + RMS_EPS), rc = 1.f / sqrtf(wave_sum(sc2) * (1.f / 512.f) + RMS_EPS);
        v4u oa, oc;
#pragma unroll
        for (int e = 0; e < 4; ++e) { oa[e] = pk2(xa[2 * e] * ra * gqv[2 * e], xa[2 * e + 1] * ra * gqv[2 * e + 1]); oc[e] = pk2(xc[2 * e] * rc * gkvv[2 * e], xc[2 * e + 1] * rc * gkvv[2 * e + 1]); }
        *((v4u*)(CQN + (size_t)m * 512) + lane) = oa; *((v4u*)(CKVN + (size_t)m * 512) + lane) = oc;
        if (lane < 32) { const float x1 = bf2f(row[1024 + lane]), x2 = bf2f(row[1056 + lane]), cc = cosT[(size_t)m * 32 + lane], ss = sinT[(size_t)m * 32 + lane];
            KR[(size_t)m * 64 + lane] = (bf16r)f2bf(x1 * cc - x2 * ss); KR[(size_t)m * 64 + 32 + lane] = (bf16r)f2bf(x1 * ss + x2 * cc); }
    }
}
__device__ __forceinline__ void sincos_d(double r, float& s, float& c) {
    const double x = r * r;
    double ps = 6.446950284384474e-26;
    ps = ps * x - 3.8681701706306835e-23; ps = ps * x + 1.9572941063391263e-20; ps = ps * x - 8.22063524662433e-18; ps = ps * x + 2.8114572543455206e-15;
    ps = ps * x - 7.647163731819816e-13; ps = ps * x + 1.6059043836821613e-10; ps = ps * x - 2.505210838544172e-8; ps = ps * x + 2.7557319223985893e-6;
    ps = ps * x - 1.984126984126984e-4; ps = ps * x + 8.333333333333333e-3; ps = ps * x - 0.16666666666666666; ps = ps * x + 1.0;
    double pc = 1.6117375710961184e-24;
    pc = pc * x - 8.896791392450574e-22; pc = pc * x + 4.110317623312165e-19; pc = pc * x - 1.5619206968586225e-16; pc = pc * x + 4.779477332387385e-14;
    pc = pc * x - 1.1470745597729725e-11; pc = pc * x + 2.08767569878681e-9; pc = pc * x - 2.755731922398589e-7; pc = pc * x + 2.48015873015873e-5;
    pc = pc * x - 1.3888888888888889e-3; pc = pc * x + 4.1666666666666664e-2; pc = pc * x - 0.5; pc = pc * x + 1.0;
    s = (float)(r * ps); c = (float)pc;
}

__device__ __forceinline__ void fox_scan(const float* logf_h, float* cks, float* wsum  ) {
    const int tid = pg8::tid_opq(), lane = tid & 63, wid = tid >> 6;
    float v[16];
#pragma unroll
    for (int q = 0; q < 4; ++q) { const f32x4 t = *(const f32x4*)(logf_h + tid * 16 + q * 4); v[4 * q] = t.x; v[4 * q + 1] = t.y; v[4 * q + 2] = t.z; v[4 * q + 3] = t.w; }
#pragma unroll
    for (int i = 1; i < 16; ++i) v[i] += v[i - 1];
    const float tot = v[15]; float sc = tot;
#pragma unroll
    for (int o = 1; o < 64; o <<= 1) { const float n = __shfl_up(sc, o); if (lane >= o) sc += n; }
    if (lane == 63) wsum[wid] = sc;
    __syncthreads();
    float pre = 0.f;
    for (int w = 0; w < wid; ++w) pre += wsum[w];
    const float excl = pre + sc - tot;
#pragma unroll
    for (int i = 0; i < 16; ++i) cks[tid * 16 + i] = (excl + v[i]) * 11.313708498984761f;
    __syncthreads();
}
__device__ __forceinline__ void moba_gate(const bf16r* Qh  , const float* kpart_h  , const float* rel_bias, int h, int qb0, int qb1,
                                          float* kmean  , float* tab  , unsigned* selb  ) {
    const int tid = pg8::tid_opq();
    for (int i = tid; i < 32 * 128; i += 512) { const int n = i >> 7, d = i & 127; kmean[i] = (kpart_h[(n * 2) * 128 + d] + kpart_h[(n * 2 + 1) * 128 + d]) * (1.f / 256.f); }
    if (tid <= 128) { int bkt; if (tid < 16) bkt = tid; else { bkt = 16 + (int)(log2f((float)tid * (1.f / 16.f)) * (16.f / 3.f)); bkt = bkt > 31 ? 31 : bkt; }
        tab[tid] = rel_bias[bkt * 8 + h] * 11.313708498984761f; }
    __syncthreads();
#pragma unroll 1
    for (int pass = 0; pass < 2; ++pass) {
        const int own = pass ? qb1 : qb0;
        if (tid < 256) {
            const bf16r* qrow = Qh + (size_t)(own * 256 + tid) * 128;
            v4u qv[16];
#pragma unroll
            for (int c = 0; c < 16; ++c) qv[c] = *((const v4u*)qrow + c);
            float v0 = -__builtin_inff(), v1 = v0, v2 = v0; int i0 = -1, i1 = -1, i2 = -1;
#pragma unroll 1
            for (int n = 0; n < own; ++n) {
                const float* km = kmean + n * 128; float g0 = 0.f, g1 = 0.f;
#pragma unroll
                for (int c = 0; c < 16; ++c) { const f32x4 k0 = *(const f32x4*)(km + c * 8), k1 = *(const f32x4*)(km + c * 8 + 4); const v4u q = qv[c];
                    g0 += __builtin_bit_cast(float, q.x << 16) * k0.x + __builtin_bit_cast(float, q.x & 0xffff0000u) * k0.y + __builtin_bit_cast(float, q.y << 16) * k0.z + __builtin_bit_cast(float, q.y & 0xffff0000u) * k0.w;
                    g1 += __builtin_bit_cast(float, q.z << 16) * k1.x + __builtin_bit_cast(float, q.z & 0xffff0000u) * k1.y + __builtin_bit_cast(float, q.w << 16) * k1.z + __builtin_bit_cast(float, q.w & 0xffff0000u) * k1.w; }
                const float g = g0 + g1;
                if (g > v0) { v2 = v1; i2 = i1; v1 = v0; i1 = i0; v0 = g; i0 = n; }
                else if (g > v1) { v2 = v1; i2 = i1; v1 = g; i1 = n; }
                else if (g > v2) { v2 = g; i2 = n; }
            }
            unsigned bits = 1u << own;
            if (i0 >= 0) bits |= 1u << i0; if (i1 >= 0) bits |= 1u << i1; if (i2 >= 0) bits |= 1u << i2;
            selb[pass * 256 + tid] = bits;
        }
    }
    __syncthreads();
}

__global__ void __launch_bounds__(512, 2) mega_fwd(Args args) {
    extern __shared__ __attribute__((aligned(16))) unsigned char lds[];
    cg::grid_group grid = cg::this_grid();
#define ARGIN(k) (args.in[k])
#define PHASE_ENV() \
    int G = gridDim.x, bx = blockIdx.x; asm volatile("" : "+s"(G), "+s"(bx)); const int tid = pg8::tid_opq(), lane = tid & 63, wave = __builtin_amdgcn_readfirstlane(tid >> 6); (void)lane; \
    const int vcu = (G % 8 == 0) ? (bx % 8) * (G / 8) + bx / 8 : bx; const int gw = vcu * 8 + wave, NGW = G * 8; \
    unsigned char* ws = args.ws; asm volatile("" : "+s"(ws)); \
    bf16r* WB = (bf16r*)(ws + WS_W); float* XF = (float*)(ws + WS_XF); bf16r* XB = (bf16r*)(ws + WS_XB); float* Z = (float*)(ws + WS_Z); bf16r* AO = (bf16r*)(ws + WS_AO); \
    unsigned char* ACT = ws + WS_ACT; float* COS = (float*)(ws + WS_COS); float* SIN = (float*)(ws + WS_SIN); float* LOGF = (float*)(ws + WS_LOGF); float* KPART = (float*)(ws + WS_KPART); \
    (void)WB; (void)XF; (void)XB; (void)Z; (void)AO; (void)ACT; (void)COS; (void)SIN; (void)LOGF; (void)KPART; (void)gw; (void)NGW; (void)vcu;
    LAS unsigned char* ldsl = (LAS unsigned char*)lds;
    const int lo = args.ph_lo, hi = args.ph_hi; int ph = 0;
#define PH_ON (ph >= lo && ph < hi)
#define PH_END do { if (ph >= lo && ph + 1 < hi) grid.sync(); ++ph; } while (0)

    if (PH_ON) {
        PHASE_ENV();
        LAS float* scr = (LAS float*)(ldsl + wave * 16384);
        int total = 0;
#pragma unroll 1
        for (int d = 0; d < 24; ++d) total += g_wdesc[d].nitems;
#pragma unroll 1
        for (int it = gw; it < total; it += NGW) {
            int r = it, d = 0;
#pragma unroll 1
            while (r >= g_wdesc[d].nitems) { r -= g_wdesc[d].nitems; ++d; }
            const WDesc wd = g_wdesc[d];
            transpose_item(args.in[wd.in_idx] + wd.src_off, wd.K, wd.N, WB + wd.dst_off, wd.mode, scr, r, lane);
        }
        { const int gt = vcu * 512 + tid, NT_ = G * 512; const v4u z4 = (v4u){0u, 0u, 0u, 0u};
          for (int i = gt; i < 2 * 192 * 2048 / 8; i += NT_) { const int j = i / (192 * 2048 / 8), r = i - j * (192 * 2048 / 8);
              *((v4u*)(WB + O_WIN_O + (size_t)j * E_WIN_O + (size_t)MLAIN * 2048) + r) = z4; }
          for (int i = gt; i < S_ * 32; i += NT_) { const int t = i >> 5, k = i & 31;
              const float inv = powf(10000.f, -(float)(2 * k) / 64.f); const float ang = (float)t * inv;
              const double a = (double)ang; const double kk = __builtin_rint(a * 0.15915494309189535); const double rr = __builtin_fma(-kk, 6.283185307179586, a);
              float s, c; sincos_d(rr, s, c); COS[i] = c; SIN[i] = s; } }
        __syncthreads();
        load_wfT((LAS float*)ldsl, ARGIN(1));
        row_phase(gw, NGW, lane, ARGIN(0), false, nullptr, nullptr, nullptr, XB, (const LAS float*)ldsl, ARGIN(2), LOGF);
        __syncthreads();
    }
    PH_END;

#pragma unroll 1
    for (int L = 0; L < 4; ++L) {
        const int odd = L & 1, j = L >> 1, nsteps = odd ? 9 : 7;
#pragma unroll 1
        for (int st = 0; st < nsteps; ++st) {
            int kind, u = -1;
            if (odd) { if (st < 4) kind = st + 1; else u = st - 4; } else { if (st == 0) kind = 0; else if (st == 1) kind = 4; else u = st - 2; }
            if (u >= 0) kind = (u == 0 || u == 3) ? 5 : (u == 2 ? 7 : 6);
            if (PH_ON) {
                PHASE_ENV();
                if (kind == 0) {
                    pg8::Gemm g{XB, WB + O_WIN_E + (size_t)j * E_WIN_E, S_, 6144, 2048}; pg8::StaticOrder So; So.init(S_, 6144, G, bx);
                    pg8::EpiHeads E{(bf16r*)ACT, 4, 8, 4, KPART};
                    pg8::gemm_phase<pg8::EpiHeads, pg8::StaticOrder, true, true>(ldsl, g, So, E);
                } else if (kind == 1) {
                    pg8::Gemm g{XB, WB + O_WIN_O + (size_t)j * E_WIN_O, S_, MLAINP, 2048}; pg8::StaticOrder So; So.init(S_, MLAINP, G, bx);
                    pg8::EpiPlain E{(bf16r*)(ACT + A_HM), MLAINP};
                    pg8::gemm_phase<pg8::EpiPlain, pg8::StaticOrder, true, true>(ldsl, g, So, E);
                } else if (kind == 2) {
                    mla_row_phase(gw, NGW, lane, (const bf16r*)(ACT + A_HM), ARGIN(6) + j * 512, ARGIN(7) + j * 512, COS, SIN,
                                  (bf16r*)(ACT + A_CQN), (bf16r*)(ACT + A_CKVN), (bf16r*)(ACT + A_KR));
                } else if (kind == 3) {
                    { pg8::Gemm g{(const bf16r*)(ACT + A_CQN), WB + O_WUQ + (size_t)j * E_WUQ, S_, 3072, 512}; pg8::StaticOrder So; So.init(S_, 3072, G, bx);
                      pg8::EpiQup E{(bf16r*)(ACT + A_QN), (bf16r*)(ACT + A_QR), COS, SIN};
                      pg8::gemm_phase<pg8::EpiQup, pg8::StaticOrder, true, true>(ldsl, g, So, E); }
                    { pg8::Gemm g{(const bf16r*)(ACT + A_CKVN), WB + O_WUKV + (size_t)j * E_WUKV, S_, 4096, 512}; pg8::StaticOrder So; So.init(S_, 4096, G, bx);
                      pg8::EpiKVup E{(bf16r*)(ACT + A_KN), (bf16r*)(ACT + A_V)};
                      pg8::gemm_phase<pg8::EpiKVup, pg8::StaticOrder, true, true>(ldsl, g, So, E); }
                } else if (kind == 4) {
                    using namespace att;
                    char* al = (char*)lds;
#pragma unroll 1
                    for (int item = vcu; item < 256; item += G) {
                        const int h16 = item >> 4, pr = item & 15, qb0 = pr, qb1 = 31 - pr;
                        const size_t HS = (size_t)S_ * 128;
                        Seam Sm;
                        if (odd) {
                            const bf16* QN = (const bf16*)(ACT + A_QN) + h16 * HS; const bf16* QR = (const bf16*)(ACT + A_QR) + (size_t)h16 * S_ * 64;
                            const bf16* KN = (const bf16*)(ACT + A_KN) + h16 * HS; const bf16* VV = (const bf16*)(ACT + A_V) + h16 * HS;
                            bf16* Oh = (bf16*)AO + h16 * 128;
                            Ctx C{(const bf16*)(ACT + A_KR), nullptr, nullptr, 0.f};
                            Ref r0{QN + (size_t)qb0 * 256 * 128, KN, VV, QR + (size_t)qb0 * 256 * 64, Oh + (size_t)qb0 * 256 * OST, qb0 * 256, nullptr};
                            Ref r1{QN + (size_t)qb1 * 256 * 128, KN, VV, QR + (size_t)qb1 * 256 * 64, Oh + (size_t)qb1 * 256 * OST, qb1 * 256, nullptr};
                            att_prime<2>(r0, C, al, Sm); att_block<2>(r0, r1, C, al, Sm); att_block<2>(r1, r1, C, al, Sm);
                        } else if (h16 < 8) {
                            const bf16* Qh = (const bf16*)ACT + (size_t)(0 * 8 + h16) * HS; const bf16* Kh = (const bf16*)ACT + (size_t)(1 * 8 + h16) * HS; const bf16* Vh = (const bf16*)ACT + (size_t)(2 * 8 + h16) * HS;
                            bf16* Oh = (bf16*)AO + h16 * 128;
                            float* cks = (float*)(al + LDS_X);
                            fox_scan(LOGF + (size_t)h16 * S_, cks, (float*)(al + 2 * SHM_V + 2 * SHM_K));
                            Ctx C{nullptr, cks, nullptr, 0.f};
                            Ref r0{Qh + (size_t)qb0 * 256 * 128, Kh, Vh, nullptr, Oh + (size_t)qb0 * 256 * OST, qb0 * 256, nullptr};
                            Ref r1{Qh + (size_t)qb1 * 256 * 128, Kh, Vh, nullptr, Oh + (size_t)qb1 * 256 * OST, qb1 * 256, nullptr};
                            att_prime<0>(r0, C, al, Sm); att_block<0>(r0, r1, C, al, Sm); att_block<0>(r1, r1, C, al, Sm);
                        } else {
                            const int h = h16 - 8;
                            const bf16* Qh = (const bf16*)ACT + (size_t)(3 * 8 + h) * HS; const bf16* Kh = (const bf16*)ACT + (size_t)(4 * 8 + h) * HS; const bf16* Vh = (const bf16*)ACT + (size_t)(5 * 8 + h) * HS;
                            bf16* Oh = (bf16*)AO + h16 * 128;
                            float* kmean = (float*)(al + LDS_X); float* tab = (float*)(al + LDS_TAB); unsigned* selb = (unsigned*)(al + LDS_SEL);
                            moba_gate((const bf16r*)Qh, KPART + (size_t)h * 32 * 2 * 128, ARGIN(4), h, qb0, qb1, kmean, tab, selb);
                            Ctx C{nullptr, nullptr, tab, tab[128]};
                            Ref r0{Qh + (size_t)qb0 * 256 * 128, Kh, Vh, nullptr, Oh + (size_t)qb0 * 256 * OST, qb0 * 256, selb};
                            Ref r1{Qh + (size_t)qb1 * 256 * 128, Kh, Vh, nullptr, Oh + (size_t)qb1 * 256 * OST, qb1 * 256, selb + 256};
                            att_prime<1>(r0, C, al, Sm); att_block<1>(r0, r1, C, al, Sm); att_block<1>(r1, r1, C, al, Sm);
                        }
                        asm volatile("s_waitcnt vmcnt(0)" ::: "memory"); __syncthreads();
                    }
                } else if (kind == 5) {
                    const bool isdown = (u == 3);
                    const bf16r* A = isdown ? (const bf16r*)ACT : AO;
                    const bf16r* Bw = isdown ? WB + O_WDN + (size_t)L * E_WDN : (odd ? WB + O_WOUT_O + (size_t)j * E_W2K : WB + O_WOUT_E + (size_t)j * E_W2K);
                    const float* xres = (!isdown && L == 0) ? ARGIN(0) : XF;
                    pg8::Gemm g{A, Bw, S_, 2048, isdown ? DFF : 2048}; pg8::StaticOrder So; So.init(S_, 2048, G, bx);
                    pg8::EpiResid E{xres, Z, ALPHA};
                    pg8::gemm_phase<pg8::EpiResid, pg8::StaticOrder, true, true>(ldsl, g, So, E);
                } else if (kind == 6) {
                    const int which = (u == 4) ? 1 : 0;
                    const float* gp = ARGIN(14) + (size_t)(L * 2 + which) * DM; const float* bp = ARGIN(15) + (size_t)(L * 2 + which) * DM;
                    const bool last = (L == 3 && which == 1);
                    const bool fg = (which == 1 && L == 1);
                    if (fg) load_wfT((LAS float*)ldsl, ARGIN(1) + (size_t)1 * 2048 * ABIN);
                    row_phase(gw, NGW, lane, Z, true, gp, bp, last ? args.out : XF, last ? nullptr : XB, (const LAS float*)ldsl, ARGIN(2) + 8, fg ? LOGF : nullptr);
                    __syncthreads();
                } else {
                    pg8::Gemm g{XB, WB + O_WGU + (size_t)L * E_WGU, S_, NGU, 2048}; pg8::StaticOrder So; So.init(S_, NGU, G, bx);
                    pg8::EpiSwiglu E{(bf16r*)ACT, DFF};
                    pg8::gemm_phase<pg8::EpiSwiglu, pg8::StaticOrder, true, true>(ldsl, g, So, E);
                }
            }
            PH_END;
        }
    }
#undef PH_ON
#undef PH_END
}

extern "C" void kernel_launch(void* const* d_in, const int* in_sizes, int n_in, void* d_out, int out_size, void* d_ws, size_t ws_size, hipStream_t stream) {
    static int grid = 0;
    if (grid == 0) {
        if (n_in != 16 || out_size != S_ * DM || ws_size < WS_END) { fprintf(stderr, "kernel_launch: unexpected shapes (n_in %d out %d ws %zu need %zu)\n", n_in, out_size, ws_size, (size_t)WS_END); grid = -1; return; }
        int dev = 0, cus = 0, per_cu = 0;
        (void)hipGetDevice(&dev); (void)hipDeviceGetAttribute(&cus, hipDeviceAttributeMultiprocessorCount, dev);
        if (hipFuncSetAttribute((const void*)mega_fwd, hipFuncAttributeMaxDynamicSharedMemorySize, LDS_BYTES) != hipSuccess) fprintf(stderr, "kernel_launch: hipFuncSetAttribute failed\n");
        if (hipOccupancyMaxActiveBlocksPerMultiprocessor(&per_cu, (const void*)mega_fwd, 512, LDS_BYTES) != hipSuccess || per_cu < 1) { fprintf(stderr, "kernel_launch: occupancy query says %d\n", per_cu); per_cu = 1; }
        (void)hipGetLastError();
        if (cus <= 0) cus = 256;
        grid = cus;
    }
    if (grid < 0) return;
    Args a{};
    for (int i = 0; i < 16; ++i) a.in[i] = (const float*)d_in[i];
    a.out = (float*)d_out; a.ws = (unsigned char*)d_ws; a.ph_lo = 0; a.ph_hi = 1000;
    void* params[] = {&a};
    hipError_t e = hipLaunchCooperativeKernel((const void*)mega_fwd, dim3(grid), dim3(512), params, LDS_BYTES, stream);
    if (e != hipSuccess) fprintf(stderr, "kernel_launch: cooperative launch failed: %s (grid %d)\n", hipGetErrorString(e), grid);
}
```

```cpp
#include <hip/hip_runtime.h>
#include <hip/hip_cooperative_groups.h>
#include <hip/hip_bf16.h>
#include <cstdio>
#include <cstdint>
#include <cmath>
namespace pg8 {
__device__ __forceinline__ int tid_opq() { int t = threadIdx.x; asm volatile("" : "+v"(t)); return t; }
#define PG8_LAS __attribute__((address_space(3)))
typedef unsigned short bf16_t;
typedef short bf16x8 __attribute__((ext_vector_type(8)));
typedef float f32x4 __attribute__((ext_vector_type(4)));
typedef unsigned u32x4 __attribute__((ext_vector_type(4)));
constexpr int BM = 256, BK = 64, HALF = 128, HTB = HALF * BK * 2  , STAGE_BYTES = 8 * HTB, NXCD = 8, WGM = 8;

__host__ __device__ __forceinline__ int lds_byte(int r, int c) { const int st = (r >> 4) * 2 + (c >> 5), rr = r & 15, cc = c & 31, ob = rr * 64 + cc * 2; return st * 1024 + (ob ^ (((ob >> 9) & 1) << 5)); }
__host__ __device__ __forceinline__ void stage_rc(int b, int& R, int& C) { const int st = b / 1024, sb = b % 1024, swz = sb ^ (((sb >> 9) & 1) << 5); R = (st >> 1) * 16 + swz / 64; C = (st & 1) * 32 + (swz % 64) / 2; }
__host__ __device__ __forceinline__ int perm32(int rho) { const int n = rho >> 4, i = rho & 15; return 8 * (i >> 2) + 4 * n + (i & 3); }

struct Unit { int pm, pn; };
struct Gemm { const bf16_t* A; const bf16_t* Bt; int M, N, K; };

struct StaticOrder {
    int nM, nN, nwg, G, c;
    __host__ __device__ void init(int M, int N, int G_, int c_) { nM = M / BM; nN = N / BM; nwg = nM * nN; G = G_; c = c_; }
    __host__ __device__ bool next(int i, Unit& u) const {
        const long L = (long)i * G + c; if (L >= nwg) return false;
        int wgid = (int)L; { const int q = nwg / NXCD, r = nwg % NXCD, xcd = wgid % NXCD, off = wgid / NXCD; wgid = (xcd < r ? xcd * (q + 1) : r * (q + 1) + (xcd - r) * q) + off; }
        const int nig = WGM * nN, gid = wgid / nig, fm = gid * WGM, gsz = (nM - fm) < WGM ? (nM - fm) : WGM;
        u.pm = fm + ((wgid % nig) % gsz); u.pn = (wgid % nig) / gsz; return true;
    }
    __device__ __forceinline__ void a_ready(const Unit&) const {}
    __device__ __forceinline__ void done(const Unit&) const {}
};

__device__ __forceinline__ unsigned cvt_pk_bf16(float lo, float hi) { unsigned r; asm volatile("v_cvt_pk_bf16_f32 %0, %1, %2" : "=v"(r) : "v"(lo), "v"(hi)); return r; }
typedef float f32x2 __attribute__((ext_vector_type(2)));
template <class Epi, class Sched, bool ALIGN_EPI = false, bool SP2 = false>
__device__ __forceinline__ void gemm_phase(PG8_LAS unsigned char* lds, const Gemm g, const Sched& S, const Epi& E) {
    const int tid = tid_opq(), wid = __builtin_amdgcn_readfirstlane(tid >> 6), lane = tid & 63, wr = wid >> 2, wc = wid & 3, fr = lane & 15, fq = lane >> 4;
    const int K = g.K, nt = K / BK;
    unsigned voffA[2], voffB[2];
#pragma unroll
    for (int i = 0; i < 2; ++i) { int R, C; stage_rc(tid * 16 + i * 8192, R, C); const int Rb = Epi::PERM ? ((R & ~31) + perm32(R & 31)) : R;
        voffA[i] = (unsigned)(R * K + C) * 2u; voffB[i] = (unsigned)(Rb * K + C) * 2u; }
    const size_t kstep = (size_t)(BK * 2);
    const size_t hstep = (size_t)HALF * K * 2;
    const size_t tstep = 2 * hstep;
    const unsigned ldsw = (unsigned)wid * 1024u;
    const int aoff = lds_byte(wr * 64 + fr, fq * 8), boff = lds_byte(wc * 32 + fr, fq * 8);
#define PG8_SA(b, h) (((b) * 2 + (h)) * HTB)
#define PG8_SB(b, h) ((4 + (b) * 2 + (h)) * HTB)
#define PG8_STAGE(bufoff, gbase, voff) do { _Pragma("unroll") for (int _i = 0; _i < 2; ++_i) \
        __builtin_amdgcn_global_load_lds((const unsigned*)((const char*)(gbase) + (voff)[_i]), (PG8_LAS unsigned*)(lds + (bufoff) + ldsw + _i * 8192), 16, 0, 0); } while (0)
#define PG8_LDA(dst, b, h) do { _Pragma("unroll") for (int m = 0; m < 4; ++m) _Pragma("unroll") for (int k = 0; k < 2; ++k) dst[m][k] = *(const PG8_LAS bf16x8*)(lds + PG8_SA(b, h) + aoff + m * 2048 + k * 1024); } while (0)
#define PG8_LDB(dst, b, h) do { _Pragma("unroll") for (int n = 0; n < 2; ++n) _Pragma("unroll") for (int k = 0; k < 2; ++k) dst[n][k] = *(const PG8_LAS bf16x8*)(lds + PG8_SB(b, h) + boff + n * 2048 + k * 1024); } while (0)
#define PG8_MMA(ai, bj, At, Bt) do { __builtin_amdgcn_s_setprio(1); _Pragma("unroll") for (int m = 0; m < 4; ++m) _Pragma("unroll") for (int n = 0; n < 2; ++n) _Pragma("unroll") for (int k = 0; k < 2; ++k) \
        acc[ai][bj][m][n] = __builtin_amdgcn_mfma_f32_16x16x32_bf16(Bt[n][k], At[m][k], acc[ai][bj][m][n], 0, 0, 0); __builtin_amdgcn_s_setprio(0); } while (0)
#define PG8_WAIT_V(n) asm volatile("s_waitcnt vmcnt(" #n ")" ::: "memory")
#define PG8_WAIT_L(n) asm volatile("s_waitcnt lgkmcnt(" #n ")" ::: "memory")
#define PG8_BAR __builtin_amdgcn_s_barrier()
#define PG8_SCHED __builtin_amdgcn_sched_barrier(0)
    Unit cur, nxt; int ui = 0;
    if (!S.next(0, cur)) return;
    f32x4 acc[2][2][4][2];
#pragma unroll
    for (int a = 0; a < 2; ++a)
#pragma unroll
        for (int b = 0; b < 2; ++b)
#pragma unroll
            for (int m = 0; m < 4; ++m)
#pragma unroll
                for (int n = 0; n < 2; ++n) acc[a][b][m][n] = (f32x4){0.f, 0.f, 0.f, 0.f};
    bf16x8 At[4][2], B0[2][2], B1[2][2];
    const char* cA = (const char*)g.A + (size_t)cur.pm * tstep; const char* cB = (const char*)g.Bt + (size_t)cur.pn * tstep;
    S.a_ready(cur);
    if constexpr (SP2) {
        PG8_STAGE(PG8_SB(0, 0), cB, voffB); PG8_STAGE(PG8_SB(0, 1), cB + hstep, voffB); PG8_STAGE(PG8_SA(0, 0), cA, voffA); PG8_STAGE(PG8_SA(0, 1), cA + hstep, voffA);
        if (wr == 1) PG8_BAR;
        PG8_WAIT_V(2); PG8_BAR;
        PG8_STAGE(PG8_SB(1, 0), cB + kstep, voffB); PG8_STAGE(PG8_SA(1, 0), cA + kstep, voffA); PG8_STAGE(PG8_SB(1, 1), cB + hstep + kstep, voffB);
        PG8_WAIT_V(6); PG8_BAR;
    } else {
        PG8_STAGE(PG8_SB(0, 0), cB, voffB); PG8_STAGE(PG8_SA(0, 0), cA, voffA); PG8_STAGE(PG8_SB(0, 1), cB + hstep, voffB); PG8_STAGE(PG8_SA(0, 1), cA + hstep, voffA);
        if (wr == 1) PG8_BAR;
        PG8_WAIT_V(4); PG8_BAR;
        PG8_STAGE(PG8_SB(1, 0), cB + kstep, voffB); PG8_STAGE(PG8_SA(1, 0), cA + kstep, voffA); PG8_STAGE(PG8_SB(1, 1), cB + hstep + kstep, voffB);
        PG8_WAIT_V(6); PG8_BAR;
    }
    for (;;) {
        const bool has_next = S.next(ui + 1, nxt);
        const char* nA = has_next ? (const char*)g.A + (size_t)nxt.pm * tstep : cA; const char* nB = has_next ? (const char*)g.Bt + (size_t)nxt.pn * tstep : cB;
        for (int t = 0; t < nt; t += 2) {
            const bool last = (t == nt - 2);
            const char* a1 = cA + (size_t)(t + 1) * kstep;
            const char* a2 = last ? nA : cA + (size_t)(t + 2) * kstep; const char* b2 = last ? nB : cB + (size_t)(t + 2) * kstep;
            const char* a3 = a2 + kstep; const char* b3 = b2 + kstep;
            if (last && has_next) S.a_ready(nxt);
            if constexpr (SP2) {
            PG8_LDB(B0, 0, 0); PG8_LDB(B1, 0, 1); PG8_SCHED; PG8_LDA(At, 0, 0); PG8_STAGE(PG8_SA(1, 1), a1 + hstep, voffA);
            PG8_WAIT_V(8); PG8_WAIT_L(0); PG8_BAR; PG8_MMA(0, 0, At, B0); PG8_MMA(0, 1, At, B1); PG8_BAR; PG8_SCHED;
            PG8_LDA(At, 0, 1); PG8_STAGE(PG8_SB(0, 0), b2, voffB); PG8_STAGE(PG8_SB(0, 1), b2 + hstep, voffB); PG8_STAGE(PG8_SA(0, 0), a2, voffA);
            PG8_WAIT_V(8); PG8_WAIT_L(0); PG8_BAR; PG8_MMA(1, 0, At, B0); PG8_MMA(1, 1, At, B1); PG8_BAR; PG8_SCHED;
            PG8_LDB(B0, 1, 0); PG8_LDB(B1, 1, 1); PG8_SCHED; PG8_LDA(At, 1, 0); PG8_STAGE(PG8_SA(0, 1), a2 + hstep, voffA);
            PG8_WAIT_V(8); PG8_WAIT_L(0); PG8_BAR; PG8_MMA(0, 0, At, B0); PG8_MMA(0, 1, At, B1); PG8_BAR; PG8_SCHED;
            PG8_LDA(At, 1, 1); PG8_STAGE(PG8_SB(1, 0), b3, voffB); PG8_STAGE(PG8_SB(1, 1), b3 + hstep, voffB); PG8_STAGE(PG8_SA(1, 0), a3, voffA);
            PG8_WAIT_V(8); PG8_WAIT_L(0); PG8_BAR; PG8_MMA(1, 0, At, B0); PG8_MMA(1, 1, At, B1); PG8_BAR; PG8_SCHED;
            } else {
            PG8_LDB(B0, 0, 0); PG8_SCHED; PG8_LDA(At, 0, 0); PG8_STAGE(PG8_SA(1, 1), a1 + hstep, voffA);
            PG8_WAIT_L(8); PG8_BAR; PG8_WAIT_L(0); PG8_MMA(0, 0, At, B0); PG8_BAR; PG8_SCHED;
            PG8_LDB(B1, 0, 1); PG8_STAGE(PG8_SB(0, 0), b2, voffB);
            PG8_BAR; PG8_WAIT_L(0); PG8_MMA(0, 1, At, B1); PG8_BAR;
            PG8_LDA(At, 0, 1); PG8_STAGE(PG8_SA(0, 0), a2, voffA);
            PG8_BAR; PG8_WAIT_L(0); PG8_MMA(1, 0, At, B0); PG8_BAR; PG8_SCHED;
            PG8_STAGE(PG8_SB(0, 1), b2 + hstep, voffB);
            PG8_WAIT_V(6); PG8_BAR; PG8_MMA(1, 1, At, B1); PG8_BAR;
            PG8_LDB(B0, 1, 0); PG8_SCHED; PG8_LDA(At, 1, 0); PG8_STAGE(PG8_SA(0, 1), a2 + hstep, voffA);
            PG8_WAIT_L(8); PG8_BAR; PG8_WAIT_L(0); PG8_MMA(0, 0, At, B0); PG8_BAR; PG8_SCHED;
            PG8_LDB(B1, 1, 1); PG8_STAGE(PG8_SB(1, 0), b3, voffB);
            PG8_BAR; PG8_WAIT_L(0); PG8_MMA(0, 1, At, B1); PG8_BAR;
            PG8_LDA(At, 1, 1); PG8_STAGE(PG8_SA(1, 0), a3, voffA);
            PG8_BAR; PG8_WAIT_L(0); PG8_MMA(1, 0, At, B0); PG8_BAR; PG8_SCHED;
            PG8_STAGE(PG8_SB(1, 1), b3 + hstep, voffB);
            PG8_WAIT_V(6); PG8_BAR; PG8_MMA(1, 1, At, B1); PG8_BAR;
            }
        }
        if constexpr (ALIGN_EPI) { if (wr == 0) PG8_BAR; }
        if constexpr (!Epi::AFTER_DRAIN) { E(acc, cur, wr, wc, fr, fq); S.done(cur); }
        if (!has_next) break;
#pragma unroll
        for (int a = 0; a < 2; ++a)
#pragma unroll
            for (int b = 0; b < 2; ++b)
#pragma unroll
                for (int m = 0; m < 4; ++m)
#pragma unroll
                    for (int n = 0; n < 2; ++n) acc[a][b][m][n] = (f32x4){0.f, 0.f, 0.f, 0.f};
        cur = nxt; cA = nA; cB = nB; ++ui;
        if constexpr (ALIGN_EPI) { if (wr == 1) PG8_BAR; }
    }
    PG8_WAIT_V(0);
    if constexpr (!ALIGN_EPI) { if (wr == 0) PG8_BAR; }
    PG8_BAR;
    if constexpr (Epi::AFTER_DRAIN) { E.fused(acc, cur, wr, wc, fr, fq, lds, wid, lane); S.done(cur); }
#undef PG8_SA
#undef PG8_SB
#undef PG8_STAGE
#undef PG8_LDA
#undef PG8_LDB
#undef PG8_MMA
#undef PG8_WAIT_V
#undef PG8_WAIT_L
#undef PG8_BAR
#undef PG8_SCHED
}
}
namespace pg8 {
typedef unsigned u32x2e __attribute__((ext_vector_type(2)));
constexpr int SEQ = 8192;
__device__ __forceinline__ u32x4 pack8bf(const f32x4 v0, const f32x4 v1) { u32x4 w; w.x = cvt_pk_bf16(v0[0], v0[1]); w.y = cvt_pk_bf16(v0[2], v0[3]); w.z = cvt_pk_bf16(v1[0], v1[1]); w.w = cvt_pk_bf16(v1[2], v1[3]); return w; }
struct EpiPlain {
    static constexpr bool PERM = true, AFTER_DRAIN = false;
    bf16_t* O; int ldc;
    __device__ __forceinline__ void operator()(const f32x4 (&acc)[2][2][4][2], const Unit& u, int wr, int wc, int fr, int fq) const {
        const int row0 = u.pm * BM + wr * 64 + fr, col0 = u.pn * BM + wc * 32 + 8 * fq;
#pragma unroll
        for (int ai = 0; ai < 2; ++ai)
#pragma unroll
            for (int m = 0; m < 4; ++m) { bf16_t* rowp = O + (size_t)(row0 + ai * HALF + m * 16) * ldc + col0;
#pragma unroll
                for (int bj = 0; bj < 2; ++bj) *(u32x4*)(rowp + bj * HALF) = pack8bf(acc[ai][bj][m][0], acc[ai][bj][m][1]); }
    }
};
struct EpiHeads {
    static constexpr bool PERM = true, AFTER_DRAIN = false;
    bf16_t* base; int tps, nh, ksec; float* kpart;
    __device__ __forceinline__ void operator()(const f32x4 (&acc)[2][2][4][2], const Unit& u, int wr, int wc, int fr, int fq) const {
        const int sec = u.pn / tps, h0 = (u.pn % tps) * 2, row0 = u.pm * BM + wr * 64 + fr, c0 = wc * 32 + 8 * fq;
#pragma unroll
        for (int bj = 0; bj < 2; ++bj) { bf16_t* hb = base + ((size_t)(sec * nh + h0 + bj) * SEQ) * 128 + c0;
#pragma unroll
            for (int ai = 0; ai < 2; ++ai)
#pragma unroll
                for (int m = 0; m < 4; ++m) *(u32x4*)(hb + (size_t)(row0 + ai * HALF + m * 16) * 128) = pack8bf(acc[ai][bj][m][0], acc[ai][bj][m][1]); }
        if (sec == ksec) {
#pragma unroll
            for (int bj = 0; bj < 2; ++bj)
#pragma unroll
                for (int n = 0; n < 2; ++n) { f32x4 s = (f32x4){0.f, 0.f, 0.f, 0.f};
#pragma unroll
                    for (int ai = 0; ai < 2; ++ai)
#pragma unroll
                        for (int m = 0; m < 4; ++m) s += acc[ai][bj][m][n];
#pragma unroll
                    for (int o = 1; o < 16; o <<= 1) { s[0] += __shfl_xor(s[0], o); s[1] += __shfl_xor(s[1], o); s[2] += __shfl_xor(s[2], o); s[3] += __shfl_xor(s[3], o); }
                    if (fr == 0) *(f32x4*)(kpart + ((size_t)((h0 + bj) * 32 + u.pm) * 2 + wr) * 128 + c0 + 4 * n) = s; }
        }
    }
};
struct EpiSwiglu {
    static constexpr bool PERM = true, AFTER_DRAIN = false;
    bf16_t* O; int ldc;
    __device__ __forceinline__ void operator()(const f32x4 (&acc)[2][2][4][2], const Unit& u, int wr, int wc, int fr, int fq) const {
        const int row0 = u.pm * BM + wr * 64 + fr, col0 = u.pn * HALF + wc * 32 + 8 * fq;
#pragma unroll
        for (int ai = 0; ai < 2; ++ai)
#pragma unroll
            for (int m = 0; m < 4; ++m) { f32x4 r[2];
#pragma unroll
                for (int n = 0; n < 2; ++n) { const f32x4 g = acc[ai][0][m][n], uu = acc[ai][1][m][n];
#pragma unroll
                    for (int j = 0; j < 4; ++j) r[n][j] = g[j] * __builtin_amdgcn_rcpf(1.f + __expf(-g[j])) * uu[j]; }
                *(u32x4*)(O + (size_t)(row0 + ai * HALF + m * 16) * ldc + col0) = pack8bf(r[0], r[1]); }
    }
};
struct EpiResid {
    static constexpr bool PERM = false, AFTER_DRAIN = false;
    const float* xres; float* z; float alpha;
    __device__ __forceinline__ void operator()(const f32x4 (&acc)[2][2][4][2], const Unit& u, int wr, int wc, int fr, int fq) const {
        const int row0 = u.pm * BM + wr * 64 + fr, col0 = u.pn * BM + wc * 32 + 4 * fq;
#pragma unroll
        for (int ai = 0; ai < 2; ++ai)
#pragma unroll
            for (int m = 0; m < 4; ++m) { const size_t off = (size_t)(row0 + ai * HALF + m * 16) * 2048 + col0;
#pragma unroll
                for (int bj = 0; bj < 2; ++bj)
#pragma unroll
                    for (int n = 0; n < 2; ++n) { const f32x4 xv = *(const f32x4*)(xres + off + bj * HALF + n * 16);
                        *(f32x4*)(z + off + bj * HALF + n * 16) = xv * alpha + acc[ai][bj][m][n]; } }
    }
};
struct EpiQup {
    static constexpr bool PERM = true, AFTER_DRAIN = false;
    bf16_t* QN; bf16_t* QR; const float* cosT; const float* sinT;
    __device__ __forceinline__ void operator()(const f32x4 (&acc)[2][2][4][2], const Unit& u, int wr, int wc, int fr, int fq) const {
        const int row0 = u.pm * BM + wr * 64 + fr;
        if (u.pn < 8) {
#pragma unroll
            for (int bj = 0; bj < 2; ++bj) { bf16_t* hb = QN + ((size_t)(u.pn * 2 + bj) * SEQ) * 128 + wc * 32 + 8 * fq;
#pragma unroll
                for (int ai = 0; ai < 2; ++ai)
#pragma unroll
                    for (int m = 0; m < 4; ++m) *(u32x4*)(hb + (size_t)(row0 + ai * HALF + m * 16) * 128) = pack8bf(acc[ai][bj][m][0], acc[ai][bj][m][1]); }
        } else {
            const int head = (u.pn - 8) * 4 + wc;
#pragma unroll
            for (int ai = 0; ai < 2; ++ai)
#pragma unroll
                for (int m = 0; m < 4; ++m) { const int row = row0 + ai * HALF + m * 16; f32x4 o1[2], o2[2];
#pragma unroll
                    for (int n = 0; n < 2; ++n) { const f32x4 c = *(const f32x4*)(cosT + (size_t)row * 32 + 8 * fq + 4 * n), s = *(const f32x4*)(sinT + (size_t)row * 32 + 8 * fq + 4 * n);
                        const f32x4 x1 = acc[ai][0][m][n], x2 = acc[ai][1][m][n]; o1[n] = x1 * c - x2 * s; o2[n] = x1 * s + x2 * c; }
                    bf16_t* dst = QR + ((size_t)head * SEQ + row) * 64 + 8 * fq;
                    *(u32x4*)dst = pack8bf(o1[0], o1[1]); *(u32x4*)(dst + 32) = pack8bf(o2[0], o2[1]); }
        }
    }
};
struct EpiKVup {
    static constexpr bool PERM = true, AFTER_DRAIN = false;
    bf16_t* KN; bf16_t* V;
    __device__ __forceinline__ void operator()(const f32x4 (&acc)[2][2][4][2], const Unit& u, int wr, int wc, int fr, int fq) const {
        const int row0 = u.pm * BM + wr * 64 + fr;
#pragma unroll
        for (int bj = 0; bj < 2; ++bj) { bf16_t* hb = (bj ? V : KN) + ((size_t)u.pn * SEQ) * 128 + wc * 32 + 8 * fq;
#pragma unroll
            for (int ai = 0; ai < 2; ++ai)
#pragma unroll
                for (int m = 0; m < 4; ++m) *(u32x4*)(hb + (size_t)(row0 + ai * HALF + m * 16) * 128) = pack8bf(acc[ai][bj][m][0], acc[ai][bj][m][1]); }
    }
};
}
namespace att {
using bf16 = __hip_bfloat16;
constexpr float THR = 8.f; constexpr int NW = 8, QBLK = 32, KVBLK = 64, QB = 256, D = 128; constexpr int SHM_V = KVBLK * D * 2, SHM_K = KVBLK * D * 2;
typedef short bf16x8 __attribute__((ext_vector_type(8)));
typedef short s16x4 __attribute__((ext_vector_type(4)));
typedef float f32x16 __attribute__((ext_vector_type(16)));
typedef float f32x4 __attribute__((ext_vector_type(4)));
typedef unsigned u32x4 __attribute__((ext_vector_type(4)));
template <class A, class Bt> struct same_t { static constexpr bool v = false; };
template <class A> struct same_t<A, A> { static constexpr bool v = true; };

#define KSWZ(row, colB) ((row) * 256 + ((colB) ^ (((row) & 7) << 4)))
#define SBAR() __builtin_amdgcn_sched_barrier(0)
__device__ __forceinline__ int v_st(int k, int c) { const int kk = (k & ~0xC) | ((k & 4) << 1) | ((k & 8) >> 1); return ((kk >> 3) * 4 + (c >> 5)) * 512 + ((kk & 7) * 32 + (c & 31)) * 2; }
__device__ __forceinline__ int v_rd_base(int lane) { return ((lane & 3) << 3) | (((lane >> 2) & 3) << 6) | (((lane >> 4) & 1) << 5) | (((lane >> 5) & 1) << 8); }
constexpr int v_rd_off(int d0, int ks, int half) { return d0 * 512 + ks * 4096 + half * 2048; }
__device__ __forceinline__ int crow(int r, int hi) { return (r & 3) + 8 * (r >> 2) + 4 * hi; }
__device__ __forceinline__ unsigned cvtpk(float lo, float hi) {
    unsigned r; asm volatile("v_cvt_pk_bf16_f32 %0, %1, %2" : "=v"(r) : "v"(lo), "v"(hi)); return r;
}
__device__ __forceinline__ bf16x8 pack8(f32x4 a, f32x4 b) {
    u32x4 w = {cvtpk(a[0], a[1]), cvtpk(a[2], a[3]), cvtpk(b[0], b[1]), cvtpk(b[2], b[3])};
    return *reinterpret_cast<bf16x8*>(&w);
}
template <class T> __device__ __forceinline__ bf16x8 load8(const T* p) {
    if constexpr (same_t<T, float>::v) { return pack8(*(const f32x4*)p, *(const f32x4*)(p + 4)); }
    else { return *reinterpret_cast<const bf16x8*>(p); }
}
__device__ __forceinline__ void mask_tile(f32x16& p0, f32x16& p1, int dq, unsigned W) {
    const float NEG = -__builtin_inff();
#pragma unroll
    for (int r = 0; r < 16; ++r) {
        const int c = (r & 3) + 8 * (r >> 2);
        if ((unsigned)(dq - c) >= W) p0[r] = NEG;
        if ((unsigned)(dq - c - 32) >= W) p1[r] = NEG;
    }
}
template <int MLA> __device__ __forceinline__ void partialSM(f32x16& p0, f32x16& p1, float& m_reg, float& mn, float& alpha) {
    constexpr float SCALE = MLA ? 0.07216878364870322f : 0.08838834764831845f;
    float pmax = p0[0]; for (int r = 1; r < 16; ++r) pmax = fmaxf(pmax, p0[r]); for (int r = 0; r < 16; ++r) pmax = fmaxf(pmax, p1[r]);
    { auto rr = __builtin_amdgcn_permlane32_swap(__float_as_uint(pmax), __float_as_uint(pmax), false, false);
      pmax = fmaxf(__uint_as_float(rr[0]), __uint_as_float(rr[1])); }
    constexpr float C2 = 1.4426950408889634f * SCALE;
    if (__builtin_expect(__all((pmax - m_reg) * SCALE <= THR), 1)) { mn = m_reg; alpha = 1.f; }
    else { mn = fmaxf(m_reg, pmax); alpha = __builtin_amdgcn_exp2f((m_reg - mn) * C2); m_reg = mn; }
    const float mnL = -mn * C2;
    for (int r = 0; r < 16; ++r) p0[r] = fmaf(p0[r], C2, mnL); for (int r = 0; r < 16; ++r) p1[r] = fmaf(p1[r], C2, mnL);
    for (int r = 0; r < 16; ++r) p0[r] = __builtin_amdgcn_exp2f(p0[r]);
}
__device__ __forceinline__ void finishSM(f32x16& p0, f32x16& p1, float alpha, float& l_reg, bf16x8& pa0, bf16x8& pa1, bf16x8& pa2, bf16x8& pa3) {
    for (int r = 0; r < 16; ++r) p1[r] = __builtin_amdgcn_exp2f(p1[r]);
    float ps = 0; for (int r = 0; r < 16; ++r) ps += p0[r]; for (int r = 0; r < 16; ++r) ps += p1[r];
    { auto rr = __builtin_amdgcn_permlane32_swap(__float_as_uint(ps), __float_as_uint(ps), false, false);
      ps = __uint_as_float(rr[0]) + __uint_as_float(rr[1]); }
    l_reg = l_reg * alpha + ps;
#define PK4(P, B_, OUT) do { unsigned a0 = cvtpk(P[B_+0], P[B_+1]), a1 = cvtpk(P[B_+2], P[B_+3]);                          \
        unsigned b0 = cvtpk(P[B_+4], P[B_+5]), b1 = cvtpk(P[B_+6], P[B_+7]);                                             \
        auto r0 = __builtin_amdgcn_permlane32_swap(a0, b0, false, false); auto r1 = __builtin_amdgcn_permlane32_swap(a1, b1, false, false); \
        u32x4 w = {r0[0], r1[0], r0[1], r1[1]}; OUT = *reinterpret_cast<bf16x8*>(&w); } while (0)
    PK4(p0, 0, pa0); PK4(p0, 8, pa1); PK4(p1, 0, pa2); PK4(p1, 8, pa3);
#undef PK4
}
template <int KB, bool SK>
__device__ __forceinline__ void qkt(f32x16& p0, f32x16& p1, const char* K_lds, int r32, int hi, const bf16x8* qr, bool act) {
    if (SK && !act) { const float NEG = -__builtin_inff();
#pragma unroll
        for (int r = 0; r < 16; ++r) { p0[r] = NEG; p1[r] = NEG; } return; }
    p0 = f32x16{}; p1 = f32x16{};
    const char* kb[4];
#pragma unroll
    for (int dd = 0; dd < 4; ++dd) kb[dd] = K_lds + KB * SHM_K + KSWZ(r32, (dd * 16 + hi * 8) * 2);
#pragma unroll
    for (int d0 = 0; d0 < 8; ++d0) { const char* a = kb[d0 & 3] + (d0 >> 2) * 128;
        bf16x8 b0 = *reinterpret_cast<const bf16x8*>(a);
        bf16x8 b1 = *reinterpret_cast<const bf16x8*>(a + 32 * 256);
        p0 = __builtin_amdgcn_mfma_f32_32x32x16_bf16(b0, qr[d0], p0, 0, 0, 0);
        p1 = __builtin_amdgcn_mfma_f32_32x32x16_bf16(b1, qr[d0], p1, 0, 0, 0); }
}
template <int VB, bool SK>
__device__ __forceinline__ void pv_tile(f32x16* o, int vb0, bf16x8 pa0, bf16x8 pa1, bf16x8 pa2, bf16x8 pa3, bool act) {
    if (SK && !act) return;
#define TRRD(dst, off) asm volatile("ds_read_b64_tr_b16 %0, %1 offset:%2" : "=&v"(dst) : "v"(vb0), "i"(off) : "memory")
#define PV_D0(d0) do { s16x4 l0, l1, l2, l3, h0, h1, h2, h3; constexpr int b_ = VB * SHM_V + v_rd_off(d0, 0, 0);     \
        TRRD(l0, b_); TRRD(h0, b_ + 2048); TRRD(l1, b_ + 4096); TRRD(h1, b_ + 6144); TRRD(l2, b_ + 8192); TRRD(h2, b_ + 10240); TRRD(l3, b_ + 12288); TRRD(h3, b_ + 14336); \
        asm volatile("s_waitcnt lgkmcnt(0)" ::: "memory"); SBAR();                 \
        o[d0] = __builtin_amdgcn_mfma_f32_32x32x16_bf16(pa0, (bf16x8){l0[0], l0[1], l0[2], l0[3], h0[0], h0[1], h0[2], h0[3]}, o[d0], 0, 0, 0);   \
        o[d0] = __builtin_amdgcn_mfma_f32_32x32x16_bf16(pa1, (bf16x8){l1[0], l1[1], l1[2], l1[3], h1[0], h1[1], h1[2], h1[3]}, o[d0], 0, 0, 0);   \
        o[d0] = __builtin_amdgcn_mfma_f32_32x32x16_bf16(pa2, (bf16x8){l2[0], l2[1], l2[2], l2[3], h2[0], h2[1], h2[2], h2[3]}, o[d0], 0, 0, 0);   \
        o[d0] = __builtin_amdgcn_mfma_f32_32x32x16_bf16(pa3, (bf16x8){l3[0], l3[1], l3[2], l3[3], h3[0], h3[1], h3[2], h3[3]}, o[d0], 0, 0, 0); } while (0)
    PV_D0(0); PV_D0(1); PV_D0(2); PV_D0(3);
#undef PV_D0
#undef TRRD
}
struct Ref { const bf16* Q; const bf16* K; const bf16* V; const bf16* Q2; bf16* O; int P0; const unsigned* selb; };
struct Ctx { const bf16* K2; const float* cks; const float* tab; float b31; };
struct Seam { bf16x8 qr[4]; bf16x8 st_v0, st_v1, st_k0, st_k1, st_r; };
constexpr int OST = 2048;
constexpr int SHM_R = 64 * 64 * 2;
constexpr int LDS_R = 2 * SHM_V + 2 * SHM_K + NW * 64 * 4;
constexpr int LDS_X = LDS_R + 2 * SHM_R;
constexpr int LDS_TAB = LDS_X + 32768;
constexpr int LDS_SEL = LDS_TAB + 1024;
constexpr int LDS_QH = LDS_SEL + 2048;
constexpr int LDS_ATT_END = LDS_QH + 32768;
#define RSWZ(row, chunk) ((row) * 128 + ((((chunk) ^ ((row) >> 1)) & 7) << 4))
template <int KB>
__device__ __forceinline__ void qkt_rope(f32x16& p0, f32x16& p1, const char* R_lds, int r32, int hi, const char* q2l) {
#pragma unroll
    for (int d0 = 0; d0 < 4; ++d0) { const char* a = R_lds + KB * SHM_R + RSWZ(r32, d0 * 2 + hi);
        bf16x8 b0 = *reinterpret_cast<const bf16x8*>(a);
        bf16x8 b1 = *reinterpret_cast<const bf16x8*>(a + 32 * 128);
        const bf16x8 qf = *reinterpret_cast<const bf16x8*>(q2l + d0 * 1024);
        p0 = __builtin_amdgcn_mfma_f32_32x32x16_bf16(b0, qf, p0, 0, 0, 0);
        p1 = __builtin_amdgcn_mfma_f32_32x32x16_bf16(b1, qf, p1, 0, 0, 0); }
}
template <int KB>
__device__ __forceinline__ void qkt_mix(f32x16& p0, f32x16& p1, const char* K_lds, int r32, int hi, const bf16x8* qr, const char* qhl) {
    p0 = f32x16{}; p1 = f32x16{};
    const char* kb[4];
#pragma unroll
    for (int dd = 0; dd < 4; ++dd) kb[dd] = K_lds + KB * SHM_K + KSWZ(r32, (dd * 16 + hi * 8) * 2);
#pragma unroll
    for (int d0 = 0; d0 < 8; ++d0) { const char* a = kb[d0 & 3] + (d0 >> 2) * 128;
        bf16x8 b0 = *reinterpret_cast<const bf16x8*>(a);
        bf16x8 b1 = *reinterpret_cast<const bf16x8*>(a + 32 * 256);
        bf16x8 qf; if (d0 < 4) qf = qr[d0]; else qf = *reinterpret_cast<const bf16x8*>(qhl + (d0 - 4) * 1024);
        p0 = __builtin_amdgcn_mfma_f32_32x32x16_bf16(b0, qf, p0, 0, 0, 0);
        p1 = __builtin_amdgcn_mfma_f32_32x32x16_bf16(b1, qf, p1, 0, 0, 0); }
}
template <int MODE>
__device__ __forceinline__ void bias_tile(f32x16& p0, f32x16& p1, const Ctx& C, int kb, int qlo, int r32, int hi, float cqs, unsigned selbits) {
    if constexpr (MODE == 0) {
        const float* ck = C.cks + kb + 4 * hi;
#pragma unroll
        for (int j = 0; j < 4; ++j) { const f32x4 a = *(const f32x4*)(ck + 8 * j), b = *(const f32x4*)(ck + 32 + 8 * j);
#pragma unroll
            for (int i = 0; i < 4; ++i) { p0[4 * j + i] += cqs - a[i]; p1[4 * j + i] += cqs - b[i]; } }
    } else if constexpr (MODE == 1) {
        const bool sel = (selbits >> (kb >> 8)) & 1u;
        if (qlo - (kb + 63) >= 128) {
            const float bb = C.b31;
#pragma unroll
            for (int r = 0; r < 16; ++r) { p0[r] += bb; p1[r] += bb; }
        } else {
            const int dq = qlo + r32 - kb - 4 * hi;
#pragma unroll
            for (int r = 0; r < 16; ++r) { const int c = (r & 3) + 8 * (r >> 2);
                int r0 = dq - c, r1 = dq - c - 32; r0 = r0 < 0 ? 0 : (r0 > 128 ? 128 : r0); r1 = r1 < 0 ? 0 : (r1 > 128 ? 128 : r1);
                p0[r] += C.tab[r0]; p1[r] += C.tab[r1]; }
        }
        if (!sel) { const float NEG = -__builtin_inff();
#pragma unroll
            for (int r = 0; r < 16; ++r) { p0[r] = NEG; p1[r] = NEG; } }
    }
}
#define ROW(p, k0, rr) ((p) + (size_t)((k0) + (rr)) * D + sc)
#define VMW() asm volatile("s_waitcnt vmcnt(0)" ::: "memory")
#define VMWN(n) asm volatile("s_waitcnt vmcnt(%0)" :: "i"(n) : "memory")
#define RLOAD(k0) do { if constexpr (MODE == 2) S.st_r = *reinterpret_cast<const bf16x8*>(C.K2 + (size_t)((k0) + (tid >> 3)) * 64 + (tid & 7) * 8); } while (0)
#define SLOAD_H(Kp, Vp, k0) do { S.st_v0 = load8<bf16>(ROW(Vp, k0, sr)); S.st_v1 = load8<bf16>(ROW(Vp, k0, 32 + sr));              \
                         S.st_k0 = load8<bf16>(ROW(Kp, k0, sr)); S.st_k1 = load8<bf16>(ROW(Kp, k0, 32 + sr)); RLOAD(k0); } while (0)
#define SWRITE_HK(bf) do { *(bf16x8*)(K_lds + (bf) * SHM_K + kws) = S.st_k0; *(bf16x8*)(K_lds + (bf) * SHM_K + kws + 32 * 256) = S.st_k1; \
                           if constexpr (MODE == 2) *(bf16x8*)(R_lds + (bf) * SHM_R + rws) = S.st_r; } while (0)
#define SWRITE_HV(bf) do { *(bf16x8*)(V_lds + (bf) * SHM_V + vst0) = S.st_v0; *(bf16x8*)(V_lds + (bf) * SHM_V + vst1) = S.st_v1; } while (0)
#define SWRITE_H(bf) do { SWRITE_HV(bf); SWRITE_HK(bf); } while (0)
template <int MODE>
__device__ __forceinline__ void att_prime(const Ref& cur, const Ctx& C, char* lds, Seam& S) {
    const int tid = pg8::tid_opq(), wid = __builtin_amdgcn_readfirstlane(tid >> 6), lane = tid & 63, r32 = lane & 31, hi = lane >> 5;
    const int sr = tid >> 4, sc = (tid & 15) * 8, kws = KSWZ(sr, sc * 2), rws = RSWZ(tid >> 3, tid & 7); char* K_lds = lds + 2 * SHM_V; char* R_lds = lds + LDS_R;
#pragma unroll
    for (int d0 = 0; d0 < 4; ++d0) S.qr[d0] = load8<bf16>(cur.Q + (size_t)(wid * QBLK + r32) * D + d0 * 16 + hi * 8);
    SLOAD_H(cur.K, cur.V, 0); VMW(); SWRITE_HK(0);
    __syncthreads();
}
template <int MODE>
__device__ __forceinline__ void att_block(const Ref& cur, const Ref& nxt, const Ctx& C, char* lds, Seam& S) {
    constexpr int MLA = (MODE == 2) ? 1 : 0;
    constexpr bool SK = false;
    constexpr int W = 0x7fffffff;
    const int tid = pg8::tid_opq(), wid = __builtin_amdgcn_readfirstlane(tid >> 6), lane = tid & 63, r32 = lane & 31, hi = lane >> 5;
    const int NT = cur.P0 / KVBLK + 4;
    const int qlo = cur.P0 + wid * QBLK, qm = qlo + r32 - 4 * hi;
    char* V_lds = lds; char* K_lds = lds + 2 * SHM_V; char* R_lds = lds + LDS_R;
    float* ws = (float*)(lds + 2 * SHM_V + 2 * SHM_K) + wid * 64; float* li_l = ws, * al_l = ws + 32;
    float m_reg = -1e30f, l_reg = 0; f32x16 o[4] = {};
    const int sr = tid >> 4, sc = (tid & 15) * 8, vst0 = v_st(sr, sc), vst1 = v_st(32 + sr, sc), kws = KSWZ(sr, sc * 2), rws = RSWZ(tid >> 3, tid & 7);
    const int vb0 = (int)(uintptr_t)V_lds + v_rd_base(lane);
    const bf16* Kh = cur.K; const bf16* Vh = cur.V;
    float cqs = 0.f; unsigned selbits = 0u;
    if constexpr (MODE == 0) cqs = C.cks[qlo + r32];
    if constexpr (MODE == 1) selbits = cur.selb[wid * QBLK + r32];
#define RESC(a) do { if (__any((a) < 1.f)) { if (hi == 0) al_l[r32] = (a); asm volatile("s_waitcnt lgkmcnt(0)" ::: "memory");              \
                     for (int d_ = 0; d_ < 4; ++d_) for (int r = 0; r < 16; ++r) o[d_][r] *= al_l[crow(r, hi)]; } } while (0)
#define KBASE(t) ((t) * KVBLK)
#define MASKT(P0_, P1_, t) do { const int kb_ = KBASE(t); bias_tile<MODE>(P0_, P1_, C, kb_, qlo, r32, hi, cqs, selbits); if (kb_ + KVBLK - 1 > qlo) mask_tile(P0_, P1_, qm - kb_, (unsigned)W); } while (0)
#define QKT(KB, PX0, PX1) do { qkt_mix<KB>(PX0, PX1, K_lds, r32, hi, S.qr, qhl); if constexpr (MODE == 2) qkt_rope<KB>(PX0, PX1, R_lds, r32, hi, q2l); } while (0)
    constexpr int NQL = 4;
#define SEAM_K0() do { VMWN(NQL); SWRITE_HK(0); SBAR(); } while (0)
    f32x16 pA0, pA1, pB0, pB1; float mnA, mnB, alA, alB; bf16x8 pa0, pa1, pa2, pa3;
    char* q2l = lds + LDS_X + wid * 4096 + lane * 16;
    char* qhl = lds + LDS_QH + wid * 4096 + lane * 16;
#pragma unroll
    for (int d0 = 4; d0 < 8; ++d0) *(bf16x8*)(qhl + (d0 - 4) * 1024) = load8<bf16>(cur.Q + (size_t)(wid * QBLK + r32) * D + d0 * 16 + hi * 8);
    if constexpr (MODE == 2) {
#pragma unroll
        for (int d0 = 0; d0 < 4; ++d0) *(bf16x8*)(q2l + d0 * 1024) = load8<bf16>(cur.Q2 + (size_t)(wid * QBLK + r32) * 64 + d0 * 16 + hi * 8); }
    SWRITE_HV(0); SBAR();
    if (NT > 1) { SLOAD_H(Kh, Vh, KBASE(1)); }
    SBAR(); QKT(0, pA0, pA1);
    MASKT(pA0, pA1, 0); partialSM<MLA>(pA0, pA1, m_reg, mnA, alA);
    if (NT > 1) { VMW(); SWRITE_H(1); }
    __syncthreads();
#define HALF_STEP(PX0, PX1, mnX, alX, PY0, PY1, alY, t, KB, VB, SB) do {                                                      \
        SBAR(); QKT(KB, PX0, PX1);                                                                                            \
        finishSM(PY0, PY1, alY, l_reg, pa0, pa1, pa2, pa3); SBAR();                                                           \
        if ((t) + 1 < NT) { SLOAD_H(Kh, Vh, KBASE((t) + 1)); SBAR(); }                                                        \
        pv_tile<VB, SK>(o, vb0, pa0, pa1, pa2, pa3, true); MASKT(PX0, PX1, (t)); partialSM<MLA>(PX0, PX1, m_reg, mnX, alX);   \
        __syncthreads();                                                                                                      \
        if ((t) + 1 < NT) { VMW(); SWRITE_H(SB); }                                                                            \
        RESC(alX); __syncthreads(); } while (0)
    for (int t = 1; t + 1 < NT; t += 2) {
        HALF_STEP(pB0, pB1, mnB, alB, pA0, pA1, alA, t, 1, 0, 0);
        HALF_STEP(pA0, pA1, mnA, alA, pB0, pB1, alB, t + 1, 0, 1, 1);
    }
    const bool even = (NT & 1) == 0;
    if (even) { SBAR(); QKT(1, pB0, pB1); SBAR(); }
    { SLOAD_H(nxt.K, nxt.V, 0); SBAR();
#pragma unroll
      for (int d0 = 0; d0 < 4; ++d0) S.qr[d0] = load8<bf16>(nxt.Q + (size_t)(wid * QBLK + r32) * D + d0 * 16 + hi * 8);
    }
    SBAR();
    finishSM(pA0, pA1, alA, l_reg, pa0, pa1, pa2, pa3); SBAR();
    pv_tile<0, SK>(o, vb0, pa0, pa1, pa2, pa3, true);
    if (even) { MASKT(pB0, pB1, NT - 1); partialSM<MLA>(pB0, pB1, m_reg, mnB, alB); __syncthreads(); RESC(alB);
        finishSM(pB0, pB1, alB, l_reg, pa0, pa1, pa2, pa3); SBAR(); pv_tile<1, SK>(o, vb0, pa0, pa1, pa2, pa3, true); }
    SBAR(); SEAM_K0();
    if (hi == 0) li_l[r32] = l_reg; asm volatile("s_waitcnt lgkmcnt(0)" ::: "memory");
    float rli[16];
#pragma unroll
    for (int r = 0; r < 16; ++r) rli[r] = __builtin_amdgcn_rcpf(li_l[crow(r, hi)]);
    bf16* Ow = cur.O + (size_t)(wid * QBLK) * OST;
#pragma unroll
    for (int r = 0; r < 16; ++r) { const int orow = crow(r, hi);
#pragma unroll
        for (int d0 = 0; d0 < 4; ++d0) { const float v = o[d0][r] * rli[r];
            const float vn = __shfl_xor(v, 1);
            if ((r32 & 1) == 0) *(unsigned*)(Ow + (size_t)orow * OST + d0 * 32 + r32) = cvtpk(v, vn); } }
    __syncthreads();
#undef RESC
#undef KBASE
#undef MASKT
#undef QKT
#undef SEAM_K0
#undef HALF_STEP
}
#undef ROW
#undef VMW
#undef VMWN
#undef RLOAD
#undef SLOAD_H
#undef SWRITE_HK
#undef SWRITE_HV
#undef SWRITE_H
#undef SBAR
#undef KSWZ
}
namespace cg = cooperative_groups;
#define LAS __attribute__((address_space(3)))
typedef unsigned short bf16r;
typedef unsigned v4u __attribute__((ext_vector_type(4)));
typedef float f32x4 __attribute__((ext_vector_type(4)));
constexpr int S_ = 8192, DM = 2048, DFF = 5632, NGU = 11264, ABIN = 6152, MLAIN = 1088, MLAINP = 1280;
constexpr float ALPHA = 1.681792830507429f;
constexpr float LN_EPS = 1e-5f, RMS_EPS = 1e-6f;
constexpr int LDS_BYTES = 155648;
constexpr size_t MiB = 1u << 20;
constexpr size_t E_WIN_E = (size_t)6144 * 2048, E_W2K = (size_t)2048 * 2048, E_WIN_O = (size_t)MLAINP * 2048, E_WUQ = (size_t)3072 * 512, E_WUKV = (size_t)4096 * 512,
                 E_WGU = (size_t)NGU * 2048, E_WDN = (size_t)2048 * DFF;
constexpr size_t O_WIN_E = 0, O_WOUT_E = O_WIN_E + 2 * E_WIN_E, O_WIN_O = O_WOUT_E + 2 * E_W2K, O_WUQ = O_WIN_O + 2 * E_WIN_O, O_WUKV = O_WUQ + 2 * E_WUQ,
                 O_WOUT_O = O_WUKV + 2 * E_WUKV, O_WGU = O_WOUT_O + 2 * E_W2K, O_WDN = O_WGU + 4 * E_WGU, O_WEND = O_WDN + 4 * E_WDN;
constexpr size_t WS_W = 0;
constexpr size_t WS_XF = ((O_WEND * 2 + MiB - 1) / MiB) * MiB;
constexpr size_t WS_XB = WS_XF + 64 * MiB;
constexpr size_t WS_Z = WS_XB + 32 * MiB;
constexpr size_t WS_AO = WS_Z + 64 * MiB;
constexpr size_t WS_ACT = WS_AO + 32 * MiB;
constexpr size_t WS_SMALL = WS_ACT + 160 * MiB;
constexpr size_t WS_COS = WS_SMALL, WS_SIN = WS_COS + 1 * MiB, WS_LOGF = WS_SIN + 1 * MiB, WS_KPART = WS_LOGF + 1 * MiB, WS_BAR = WS_KPART + 512 * 1024, WS_END = WS_KPART + 1 * MiB;
constexpr size_t A_HM = 0, A_CQN = 20 * MiB, A_CKVN = 28 * MiB, A_KR = 36 * MiB, A_QN = 40 * MiB, A_QR = 72 * MiB, A_KN = 88 * MiB, A_V = 120 * MiB;

struct Args { const float* in[16]; float* out; unsigned char* ws; int ph_lo, ph_hi; };

__device__ __forceinline__ unsigned f2bf(float f) { unsigned u = __builtin_bit_cast(unsigned, f); return (u + 0x7fffu + ((u >> 16) & 1u)) >> 16; }
__device__ __forceinline__ unsigned pk2(float lo, float hi) { return f2bf(lo) | (f2bf(hi) << 16); }
__device__ __forceinline__ float bf2f(unsigned short b) { return __builtin_bit_cast(float, (unsigned)b << 16); }
__device__ __forceinline__ float wave_sum(float v) {
#pragma unroll
    for (int o = 1; o < 64; o <<= 1) v += __shfl_xor(v, o);
    return v;
}
#define LDS_WAIT() asm volatile("s_waitcnt lgkmcnt(0)" ::: "memory")

__device__ __forceinline__ int map_row(int mode, int n) {
    switch (mode) {
        case 1: return n < 3072 ? n : (n < 3080 ? -1 : n - 8);
        case 2: { const int h = n / 192, d = n % 192; if (d < 128) return h * 128 + d; const int r = d - 128; return 2048 + (h >> 2) * 256 + (r >> 5) * 128 + (h & 3) * 32 + (r & 31); }
        case 3: return (n >> 7) * 256 + (n & 127);
        case 4: return (n >> 7) * 256 + 128 + (n & 127);
        default: return n;
    }
}
__device__ __forceinline__ void transpose_item(const float* W, int K, int N, bf16r* WT, int mode, LAS float* scr, int item, int lane) {
    const int nblk = (N + 31) >> 5, kb = item / nblk, nb = item - kb * nblk, k0 = 64 * kb, n0 = 32 * nb;
    const int nn = n0 + (lane & 31); const bool okn = nn < N;
#pragma unroll 8
    for (int i = 0; i < 32; ++i) { const int kk = 2 * i + (lane >> 5); scr[kk * 33 + (lane & 31)] = okn ? W[(size_t)(k0 + kk) * N + nn] : 0.f; }
    LDS_WAIT(); asm volatile("" ::: "memory");
    const int c = lane & 7;
#pragma unroll
    for (int j = 0; j < 4; ++j) { const int n = (lane >> 3) + 8 * j; const LAS float* s = scr + (8 * c) * 33 + n;
        v4u o; o.x = pk2(s[0 * 33], s[1 * 33]); o.y = pk2(s[2 * 33], s[3 * 33]); o.z = pk2(s[4 * 33], s[5 * 33]); o.w = pk2(s[6 * 33], s[7 * 33]);
        const int gn = n0 + n; const int dr = gn < N ? map_row(mode, gn) : -1;
        if (dr >= 0) *(v4u*)(WT + (size_t)dr * K + k0 + 8 * c) = o; }
    LDS_WAIT(); asm volatile("" ::: "memory");
}
struct WDesc { int in_idx; unsigned src_off; int K, N, mode; unsigned dst_off; int nitems; };
#define WD(ii, so, K_, N_, md, dof) { ii, (unsigned)(so), K_, N_, md, (unsigned)(dof), ((K_) / 64) * (((N_) + 31) / 32) }
__constant__ WDesc g_wdesc[24] = {
    WD(1, 0, 2048, ABIN, 1, O_WIN_E), WD(1, (size_t)2048 * ABIN, 2048, ABIN, 1, O_WIN_E + E_WIN_E),
    WD(3, 0, 2048, 2048, 0, O_WOUT_E), WD(3, E_W2K, 2048, 2048, 0, O_WOUT_E + E_W2K),
    WD(5, 0, 2048, MLAIN, 0, O_WIN_O), WD(5, (size_t)2048 * MLAIN, 2048, MLAIN, 0, O_WIN_O + E_WIN_O),
    WD(8, 0, 512, 3072, 2, O_WUQ), WD(8, E_WUQ, 512, 3072, 2, O_WUQ + E_WUQ),
    WD(9, 0, 512, 4096, 0, O_WUKV), WD(9, E_WUKV, 512, 4096, 0, O_WUKV + E_WUKV),
    WD(10, 0, 2048, 2048, 0, O_WOUT_O), WD(10, E_W2K, 2048, 2048, 0, O_WOUT_O + E_W2K),
    WD(11, 0, 2048, DFF, 3, O_WGU), WD(11, (size_t)2048 * DFF, 2048, DFF, 3, O_WGU + E_WGU), WD(11, (size_t)2 * 2048 * DFF, 2048, DFF, 3, O_WGU + 2 * E_WGU), WD(11, (size_t)3 * 2048 * DFF, 2048, DFF, 3, O_WGU + 3 * E_WGU),
    WD(12, 0, 2048, DFF, 4, O_WGU), WD(12, (size_t)2048 * DFF, 2048, DFF, 4, O_WGU + E_WGU), WD(12, (size_t)2 * 2048 * DFF, 2048, DFF, 4, O_WGU + 2 * E_WGU), WD(12, (size_t)3 * 2048 * DFF, 2048, DFF, 4, O_WGU + 3 * E_WGU),
    WD(13, 0, DFF, 2048, 0, O_WDN), WD(13, E_WDN, DFF, 2048, 0, O_WDN + E_WDN), WD(13, 2 * E_WDN, DFF, 2048, 0, O_WDN + 2 * E_WDN), WD(13, 3 * E_WDN, DFF, 2048, 0, O_WDN + 3 * E_WDN)
};
#undef WD

__device__ __forceinline__ void load_wfT(LAS float* wfT, const float* Win  ) {
    for (int idx = pg8::tid_opq(); idx < 16384; idx += 512) { const int k = idx >> 3, h = idx & 7; wfT[h * 2048 + k] = Win[(size_t)k * ABIN + 3072 + h]; }
    __syncthreads();
}
__device__ __forceinline__ void row_phase(int gw, int NGW, int lane, const float* src, bool do_ln, const float* g, const float* b, float* dst_f, bf16r* dst_b,
                                          const LAS float* wfT, const float* fbias, float* logf) {
    for (int m = gw; m < S_; m += NGW) {
        const f32x4* xr = (const f32x4*)(src + (size_t)m * DM) + lane;
        f32x4 v[8];
#pragma unroll
        for (int j = 0; j < 8; ++j) v[j] = xr[64 * j];
        if (do_ln) {
            float s = 0.f;
#pragma unroll
            for (int j = 0; j < 8; ++j) s += (v[j].x + v[j].y) + (v[j].z + v[j].w);
            const float mean = wave_sum(s) * (1.f / DM); float s2 = 0.f;
#pragma unroll
            for (int j = 0; j < 8; ++j) { v[j] = v[j] - mean; s2 += (v[j].x * v[j].x + v[j].y * v[j].y) + (v[j].z * v[j].z + v[j].w * v[j].w); }
            const float rstd = 1.f / sqrtf(wave_sum(s2) * (1.f / DM) + LN_EPS);
#pragma unroll
            for (int j = 0; j < 8; ++j) { const f32x4 gg = *((const f32x4*)g + lane + 64 * j), bb = *((const f32x4*)b + lane + 64 * j); v[j] = v[j] * rstd * gg + bb; }
        }
        if (dst_f) { f32x4* o = (f32x4*)(dst_f + (size_t)m * DM) + lane;
#pragma unroll
            for (int j = 0; j < 8; ++j) o[64 * j] = v[j]; }
        if (dst_b) { unsigned long long* o8 = (unsigned long long*)(dst_b + (size_t)m * DM) + lane;
#pragma unroll
            for (int j = 0; j < 8; ++j) o8[64 * j] = (unsigned long long)pk2(v[j].x, v[j].y) | ((unsigned long long)pk2(v[j].z, v[j].w) << 32); }
        if (logf) {
            float mine = 0.f;
#pragma unroll 1
            for (int h = 0; h < 8; ++h) { float a = 0.f;
#pragma unroll
                for (int j = 0; j < 8; ++j) { const f32x4 w = *((const LAS f32x4*)(wfT + h * 2048) + lane + 64 * j); a += (v[j].x * w.x + v[j].y * w.y) + (v[j].z * w.z + v[j].w * w.w); }
                a = wave_sum(a); if (lane == h) mine = a; }
            if (lane < 8) { const float zf = mine + fbias[lane];
                logf[(size_t)lane * S_ + m] = fminf(zf, 0.f) - log1pf(__expf(-fabsf(zf))); }
        }
    }
}
__device__ __forceinline__ void mla_row_phase(int gw, int NGW, int lane, const bf16r* HM, const float* gq, const float* gkv, const float* cosT, const float* sinT,
                                              bf16r* CQN, bf16r* CKVN, bf16r* KR) {
    float gqv[8], gkvv[8];
#pragma unroll
    for (int e = 0; e < 8; ++e) { gqv[e] = gq[8 * lane + e]; gkvv[e] = gkv[8 * lane + e]; }
    for (int m = gw; m < S_; m += NGW) {
        const bf16r* row = HM + (size_t)m * MLAINP;
        const v4u a = *((const v4u*)row + lane), c = *((const v4u*)(row + 512) + lane);
        float xa[8], xc[8];
#pragma unroll
        for (int e = 0; e < 4; ++e) { xa[2 * e] = __builtin_bit_cast(float, a[e] << 16); xa[2 * e + 1] = __builtin_bit_cast(float, a[e] & 0xffff0000u);
                                      xc[2 * e] = __builtin_bit_cast(float, c[e] << 16); xc[2 * e + 1] = __builtin_bit_cast(float, c[e] & 0xffff0000u); }
        float sa = 0.f, sc2 = 0.f;
#pragma unroll
        for (int e = 0; e < 8; ++e) { sa += xa[e] * xa[e]; sc2 += xc[e] * xc[e]; }
        const float ra = 1.f / sqrtf(wave_sum(sa) * (1.f / 512.f) + RMS_EPS), rc = 1.f / sqrtf(wave_sum(sc2) * (1.f / 512.f) + RMS_EPS);
        v4u oa, oc;
#pragma unroll
        for (int e = 0; e < 4; ++e) { oa[e] = pk2(xa[2 * e] * ra * gqv[2 * e], xa[2 * e + 1] * ra * gqv[2 * e + 1]); oc[e] = pk2(xc[2 * e] * rc * gkvv[2 * e], xc[2 * e + 1] * rc * gkvv[2 * e + 1]); }
        *((v4u*)(CQN + (size_t)m * 512) + lane) = oa; *((v4u*)(CKVN + (size_t)m * 512) + lane) = oc;
        if (lane < 32) { const float x1 = bf2f(row[1024 + lane]), x2 = bf2f(row[1056 + lane]), cc = cosT[(size_t)m * 32 + lane], ss = sinT[(size_t)m * 32 + lane];
            KR[(size_t)m * 64 + lane] = (bf16r)f2bf(x1 * cc - x2 * ss); KR[(size_t)m * 64 + 32 + lane] = (bf16r)f2bf(x1 * ss + x2 * cc); }
    }
}
__device__ __forceinline__ void sincos_d(double r, float& s, float& c) {
    const double x = r * r;
    double ps = 6.446950284384474e-26;
    ps = ps * x - 3.8681701706306835e-23; ps = ps * x + 1.9572941063391263e-20; ps = ps * x - 8.22063524662433e-18; ps = ps * x + 2.8114572543455206e-15;
    ps = ps * x - 7.647163731819816e-13; ps = ps * x + 1.6059043836821613e-10; ps = ps * x - 2.505210838544172e-8; ps = ps * x + 2.7557319223985893e-6;
    ps = ps * x - 1.984126984126984e-4; ps = ps * x + 8.333333333333333e-3; ps = ps * x - 0.16666666666666666; ps = ps * x + 1.0;
    double pc = 1.6117375710961184e-24;
    pc = pc * x - 8.896791392450574e-22; pc = pc * x + 4.110317623312165e-19; pc = pc * x - 1.5619206968586225e-16; pc = pc * x + 4.779477332387385e-14;
    pc = pc * x - 1.1470745597729725e-11; pc = pc * x + 2.08767569878681e-9; pc = pc * x - 2.755731922398589e-7; pc = pc * x + 2.48015873015873e-5;
    pc = pc * x - 1.3888888888888889e-3; pc = pc * x + 4.1666666666666664e-2; pc = pc * x - 0.5; pc = pc * x + 1.0;
    s = (float)(r * ps); c = (float)pc;
}

__device__ __forceinline__ void fox_scan(const float* logf_h, float* cks, float* wsum  ) {
    const int tid = pg8::tid_opq(), lane = tid & 63, wid = tid >> 6;
    float v[16];
#pragma unroll
    for (int q = 0; q < 4; ++q) { const f32x4 t = *(const f32x4*)(logf_h + tid * 16 + q * 4); v[4 * q] = t.x; v[4 * q + 1] = t.y; v[4 * q + 2] = t.z; v[4 * q + 3] = t.w; }
#pragma unroll
    for (int i = 1; i < 16; ++i) v[i] += v[i - 1];
    const float tot = v[15]; float sc = tot;
#pragma unroll
    for (int o = 1; o < 64; o <<= 1) { const float n = __shfl_up(sc, o); if (lane >= o) sc += n; }
    if (lane == 63) wsum[wid] = sc;
    __syncthreads();
    float pre = 0.f;
    for (int w = 0; w < wid; ++w) pre += wsum[w];
    const float excl = pre + sc - tot;
#pragma unroll
    for (int i = 0; i < 16; ++i) cks[tid * 16 + i] = (excl + v[i]) * 11.313708498984761f;
    __syncthreads();
}
__device__ __forceinline__ void moba_gate(const bf16r* Qh  , const float* kpart_h  , const float* rel_bias, int h, int qb0, int qb1,
                                          float* kmean  , float* tab  , unsigned* selb  ) {
    const int tid = pg8::tid_opq();
    for (int i = tid; i < 32 * 128; i += 512) { const int n = i >> 7, d = i & 127; kmean[i] = (kpart_h[(n * 2) * 128 + d] + kpart_h[(n * 2 + 1) * 128 + d]) * (1.f / 256.f); }
    if (tid <= 128) { int bkt; if (tid < 16) bkt = tid; else { bkt = 16 + (int)(log2f((float)tid * (1.f / 16.f)) * (16.f / 3.f)); bkt = bkt > 31 ? 31 : bkt; }
        tab[tid] = rel_bias[bkt * 8 + h] * 11.313708498984761f; }
    __syncthreads();
#pragma unroll 1
    for (int pass = 0; pass < 2; ++pass) {
        const int own = pass ? qb1 : qb0;
        if (tid < 256) {
            const bf16r* qrow = Qh + (size_t)(own * 256 + tid) * 128;
            v4u qv[16];
#pragma unroll
            for (int c = 0; c < 16; ++c) qv[c] = *((const v4u*)qrow + c);
            float v0 = -__builtin_inff(), v1 = v0, v2 = v0; int i0 = -1, i1 = -1, i2 = -1;
#pragma unroll 1
            for (int n = 0; n < own; ++n) {
                const float* km = kmean + n * 128; float g0 = 0.f, g1 = 0.f;
#pragma unroll
                for (int c = 0; c < 16; ++c) { const f32x4 k0 = *(const f32x4*)(km + c * 8), k1 = *(const f32x4*)(km + c * 8 + 4); const v4u q = qv[c];
                    g0 += __builtin_bit_cast(float, q.x << 16) * k0.x + __builtin_bit_cast(float, q.x & 0xffff0000u) * k0.y + __builtin_bit_cast(float, q.y << 16) * k0.z + __builtin_bit_cast(float, q.y & 0xffff0000u) * k0.w;
                    g1 += __builtin_bit_cast(float, q.z << 16) * k1.x + __builtin_bit_cast(float, q.z & 0xffff0000u) * k1.y + __builtin_bit_cast(float, q.w << 16) * k1.z + __builtin_bit_cast(float, q.w & 0xffff0000u) * k1.w; }
                const float g = g0 + g1;
                if (g > v0) { v2 = v1; i2 = i1; v1 = v0; i1 = i0; v0 = g; i0 = n; }
                else if (g > v1) { v2 = v1; i2 = i1; v1 = g; i1 = n; }
                else if (g > v2) { v2 = g; i2 = n; }
            }
            unsigned bits = 1u << own;
            if (i0 >= 0) bits |= 1u << i0; if (i1 >= 0) bits |= 1u << i1; if (i2 >= 0) bits |= 1u << i2;
            selb[pass * 256 + tid] = bits;
        }
    }
    __syncthreads();
}

#define RLX_AGENT __ATOMIC_RELAXED, __HIP_MEMORY_SCOPE_AGENT
#define XB_TMO      128
#define XB_XCNT(j)  (256  + 64 * (j))
#define XB_XSUB(j)  (1280 + 64 * (j))
#define XB_XGEN(j)  (2304 + 64 * (j))
#define XB_TOP      3328
#define XB_TOPGEN   3392
#define XCD_BAR_WORDS 3456
#define XB_SPIN_CAP (1u << 18)

__device__ __forceinline__ unsigned xb_ld(unsigned* p)              { return __hip_atomic_load(p, __ATOMIC_RELAXED, __HIP_MEMORY_SCOPE_AGENT); }
__device__ __forceinline__ unsigned xb_add(unsigned* p, unsigned v) { return __hip_atomic_fetch_add(p, v, __ATOMIC_RELAXED, __HIP_MEMORY_SCOPE_AGENT); }
__device__ __forceinline__ unsigned xb_xcc_id() { return (unsigned)__builtin_amdgcn_s_getreg((3 << 11) | 20) & 0xFu; }
#define XB_SPIN(cond, bar) do { unsigned _sp = 0; while (cond) { __builtin_amdgcn_s_sleep(1); \
    if ((++_sp & 255u) == 0u) { if (xb_ld(&(bar)[XB_TMO])) break; if (_sp > XB_SPIN_CAP) { atomicAdd(&(bar)[XB_TMO], 1u); break; } } } } while (0)

struct XcdBarrier {
    unsigned* bar; unsigned x;
    volatile LAS unsigned* st;
};

__device__ __forceinline__ XcdBarrier xcd_barrier_post(unsigned* bar, volatile LAS unsigned* st) {
    XcdBarrier b; b.bar = bar; b.x = xb_xcc_id(); b.st = st;
    if (threadIdx.x == 0) (void)xb_add(&bar[XB_XCNT(b.x)], 1u);
    return b;
}
__device__ __forceinline__ void xcd_barrier_complete(unsigned* bar, unsigned x, unsigned& nloc, unsigned& nx) {
    const unsigned G = gridDim.x * gridDim.y * gridDim.z;
    unsigned sum, cnt, mine, sp = 0u;
    for (;;) {
        sum = 0u; cnt = 0u; mine = 0u;
#pragma unroll
        for (unsigned j = 0; j < 16; ++j) { const unsigned c = xb_ld(&bar[XB_XCNT(j)]); sum += c; cnt += (c > 0u) ? 1u : 0u; mine = (j == x) ? c : mine; }
        if (sum == G) break;
        __builtin_amdgcn_s_sleep(1);
        if ((++sp & 255u) == 0u) { if (xb_ld(&bar[XB_TMO])) break; if (sp > XB_SPIN_CAP) { atomicAdd(&bar[XB_TMO], 1u); break; } }
    }
    nloc = mine > 0u ? mine : 1u; nx = cnt > 0u ? cnt : 1u;
}

__device__ __forceinline__ void xcd_barrier(const XcdBarrier& b) {
    asm volatile("s_waitcnt vmcnt(0)" ::: "memory");
    __syncthreads();
    if (threadIdx.x == 0) {
        unsigned* bar = b.bar;
        __builtin_amdgcn_s_waitcnt(0);
        unsigned nloc = b.st[0], nx = b.st[1];
        if (nloc == 0u) { xcd_barrier_complete(bar, b.x, nloc, nx); b.st[0] = nloc; b.st[1] = nx; }
        const unsigned old = xb_add(&bar[XB_XSUB(b.x)], 1u);
        const unsigned gen = old / nloc;
        if (old + 1u == (gen + 1u) * nloc) {
            __builtin_amdgcn_fence(__ATOMIC_RELEASE, "agent");
            asm volatile("s_waitcnt vmcnt(0)" ::: "memory");
            const unsigned og = xb_add(&bar[XB_TOP], 1u);
            const unsigned tg = og / nx;
            if (og + 1u == (tg + 1u) * nx) xb_add(&bar[XB_TOPGEN], 1u);
            else XB_SPIN(xb_ld(&bar[XB_TOPGEN]) == tg, bar);
            __builtin_amdgcn_fence(__ATOMIC_ACQUIRE, "agent");
            xb_add(&bar[XB_XGEN(b.x)], 1u);
            asm volatile("s_waitcnt vmcnt(0)" ::: "memory");
        } else {
            XB_SPIN(xb_ld(&bar[XB_XGEN(b.x)]) == gen, bar);
            __builtin_amdgcn_fence(__ATOMIC_ACQUIRE, "agent");
            asm volatile("s_waitcnt vmcnt(0)" ::: "memory");
        }
    }
    __syncthreads();
}

#ifndef PROBE_DUP
#define PROBE_DUP 0
#endif
__global__ void __launch_bounds__(512, 2) mega_fwd(Args args) {
    extern __shared__ __attribute__((aligned(16))) unsigned char lds[];
    cg::grid_group grid = cg::this_grid();
#define ARGIN(k) (args.in[k])
#define PHASE_ENV() \
    int G = gridDim.x, bx = blockIdx.x; asm volatile("" : "+s"(G), "+s"(bx)); const int tid = pg8::tid_opq(), lane = tid & 63, wave = __builtin_amdgcn_readfirstlane(tid >> 6); (void)lane; \
    const int vcu = (G % 8 == 0) ? (bx % 8) * (G / 8) + bx / 8 : bx; const int gw = vcu * 8 + wave, NGW = G * 8; \
    unsigned char* ws = args.ws; asm volatile("" : "+s"(ws)); \
    bf16r* WB = (bf16r*)(ws + WS_W); float* XF = (float*)(ws + WS_XF); bf16r* XB = (bf16r*)(ws + WS_XB); float* Z = (float*)(ws + WS_Z); bf16r* AO = (bf16r*)(ws + WS_AO); \
    unsigned char* ACT = ws + WS_ACT; float* COS = (float*)(ws + WS_COS); float* SIN = (float*)(ws + WS_SIN); float* LOGF = (float*)(ws + WS_LOGF); float* KPART = (float*)(ws + WS_KPART); \
    (void)WB; (void)XF; (void)XB; (void)Z; (void)AO; (void)ACT; (void)COS; (void)SIN; (void)LOGF; (void)KPART; (void)gw; (void)NGW; (void)vcu;
    LAS unsigned char* ldsl = (LAS unsigned char*)lds;
    int ph = 0; constexpr int nph = 1 + 7 + 9 + 7 + 9;
    unsigned* barw = (unsigned*)(args.ws + WS_BAR);
    if (blockIdx.x == 0) for (int i = threadIdx.x; i < XCD_BAR_WORDS; i += 512) barw[i] = 0u;
    if (threadIdx.x < 16) ((LAS unsigned*)(ldsl + LDS_BYTES - 64))[threadIdx.x] = 0u;
    __syncthreads();
    XcdBarrier xbar; xbar.bar = barw; xbar.x = 0; xbar.st = nullptr;
#define PH_ON (true)
#define PH_END do { if (ph == 0) { grid.sync(); xbar = xcd_barrier_post(barw, (volatile LAS unsigned*)(ldsl + LDS_BYTES - 64)); } else if (ph + 1 < nph) { xcd_barrier(xbar); if (PROBE_DUP & 16) { xcd_barrier(xbar); xcd_barrier(xbar); } } ++ph; } while (0)

    if (PH_ON) {
#pragma unroll 1
      for (int rep = 0; rep < ((PROBE_DUP & 1) ? 2 : 1); ++rep) {
        PHASE_ENV();
        LAS float* scr = (LAS float*)(ldsl + wave * 16384);
        int total = 0;
#pragma unroll 1
        for (int d = 0; d < 24; ++d) total += g_wdesc[d].nitems;
#pragma unroll 1
        for (int it = gw; it < total; it += NGW) {
            int r = it, d = 0;
#pragma unroll 1
            while (r >= g_wdesc[d].nitems) { r -= g_wdesc[d].nitems; ++d; }
            const WDesc wd = g_wdesc[d];
            transpose_item(args.in[wd.in_idx] + wd.src_off, wd.K, wd.N, WB + wd.dst_off, wd.mode, scr, r, lane);
        }
        { const int gt = vcu * 512 + tid, NT_ = G * 512; const v4u z4 = (v4u){0u, 0u, 0u, 0u};
          for (int i = gt; i < 2 * 192 * 2048 / 8; i += NT_) { const int j = i / (192 * 2048 / 8), r = i - j * (192 * 2048 / 8);
              *((v4u*)(WB + O_WIN_O + (size_t)j * E_WIN_O + (size_t)MLAIN * 2048) + r) = z4; }
          for (int i = gt; i < S_ * 32; i += NT_) { const int t = i >> 5, k = i & 31;
              const float inv = powf(10000.f, -(float)(2 * k) / 64.f); const float ang = (float)t * inv;
              const double a = (double)ang; const double kk = __builtin_rint(a * 0.15915494309189535); const double rr = __builtin_fma(-kk, 6.283185307179586, a);
              float s, c; sincos_d(rr, s, c); COS[i] = c; SIN[i] = s; } }
        __syncthreads();
        load_wfT((LAS float*)ldsl, ARGIN(1));
        row_phase(gw, NGW, lane, ARGIN(0), false, nullptr, nullptr, nullptr, XB, (const LAS float*)ldsl, ARGIN(2), LOGF);
        __syncthreads();
      }
    }
    PH_END;

#pragma unroll 1
    for (int L = 0; L < 4; ++L) {
        const int odd = L & 1, j = L >> 1, nsteps = odd ? 9 : 7;
#pragma unroll 1
        for (int st = 0; st < nsteps; ++st) {
            int kind, u = -1;
            if (odd) { if (st < 4) kind = st + 1; else u = st - 4; } else { if (st == 0) kind = 0; else if (st == 1) kind = 4; else u = st - 2; }
            if (u >= 0) kind = (u == 0 || u == 3) ? 5 : (u == 2 ? 7 : 6);
            if (PH_ON) {
              const int dupmask = (kind == 4) ? 2 : ((kind == 6 || kind == 2) ? 4 : 8);
#pragma unroll 1
              for (int rep = 0; rep < ((PROBE_DUP & dupmask) ? 2 : 1); ++rep) {
                PHASE_ENV();
                if (kind == 0) {
                    pg8::Gemm g{XB, WB + O_WIN_E + (size_t)j * E_WIN_E, S_, 6144, 2048}; pg8::StaticOrder So; So.init(S_, 6144, G, bx);
                    pg8::EpiHeads E{(bf16r*)ACT, 4, 8, 4, KPART};
                    pg8::gemm_phase<pg8::EpiHeads, pg8::StaticOrder, true, true>(ldsl, g, So, E);
                } else if (kind == 1) {
                    pg8::Gemm g{XB, WB + O_WIN_O + (size_t)j * E_WIN_O, S_, MLAINP, 2048}; pg8::StaticOrder So; So.init(S_, MLAINP, G, bx);
                    pg8::EpiPlain E{(bf16r*)(ACT + A_HM), MLAINP};
                    pg8::gemm_phase<pg8::EpiPlain, pg8::StaticOrder, true, true>(ldsl, g, So, E);
                } else if (kind == 2) {
                    mla_row_phase(gw, NGW, lane, (const bf16r*)(ACT + A_HM), ARGIN(6) + j * 512, ARGIN(7) + j * 512, COS, SIN,
                                  (bf16r*)(ACT + A_CQN), (bf16r*)(ACT + A_CKVN), (bf16r*)(ACT + A_KR));
                } else if (kind == 3) {
                    { pg8::Gemm g{(const bf16r*)(ACT + A_CQN), WB + O_WUQ + (size_t)j * E_WUQ, S_, 3072, 512}; pg8::StaticOrder So; So.init(S_, 3072, G, bx);
                      pg8::EpiQup E{(bf16r*)(ACT + A_QN), (bf16r*)(ACT + A_QR), COS, SIN};
                      pg8::gemm_phase<pg8::EpiQup, pg8::StaticOrder, true, true>(ldsl, g, So, E); }
                    { pg8::Gemm g{(const bf16r*)(ACT + A_CKVN), WB + O_WUKV + (size_t)j * E_WUKV, S_, 4096, 512}; pg8::StaticOrder So; So.init(S_, 4096, G, bx);
                      pg8::EpiKVup E{(bf16r*)(ACT + A_KN), (bf16r*)(ACT + A_V)};
                      pg8::gemm_phase<pg8::EpiKVup, pg8::StaticOrder, true, true>(ldsl, g, So, E); }
                } else if (kind == 4) {
                    using namespace att;
                    char* al = (char*)lds;
#pragma unroll 1
                    for (int item = vcu; item < 256; item += G) {
                        const int h16 = item >> 4, pr = item & 15, qb0 = pr, qb1 = 31 - pr;
                        const size_t HS = (size_t)S_ * 128;
                        Seam Sm;
                        if (odd) {
                            const bf16* QN = (const bf16*)(ACT + A_QN) + h16 * HS; const bf16* QR = (const bf16*)(ACT + A_QR) + (size_t)h16 * S_ * 64;
                            const bf16* KN = (const bf16*)(ACT + A_KN) + h16 * HS; const bf16* VV = (const bf16*)(ACT + A_V) + h16 * HS;
                            bf16* Oh = (bf16*)AO + h16 * 128;
                            Ctx C{(const bf16*)(ACT + A_KR), nullptr, nullptr, 0.f};
                            Ref r0{QN + (size_t)qb0 * 256 * 128, KN, VV, QR + (size_t)qb0 * 256 * 64, Oh + (size_t)qb0 * 256 * OST, qb0 * 256, nullptr};
                            Ref r1{QN + (size_t)qb1 * 256 * 128, KN, VV, QR + (size_t)qb1 * 256 * 64, Oh + (size_t)qb1 * 256 * OST, qb1 * 256, nullptr};
                            att_prime<2>(r0, C, al, Sm); att_block<2>(r0, r1, C, al, Sm); att_block<2>(r1, r1, C, al, Sm);
                        } else if (h16 < 8) {
                            const bf16* Qh = (const bf16*)ACT + (size_t)(0 * 8 + h16) * HS; const bf16* Kh = (const bf16*)ACT + (size_t)(1 * 8 + h16) * HS; const bf16* Vh = (const bf16*)ACT + (size_t)(2 * 8 + h16) * HS;
                            bf16* Oh = (bf16*)AO + h16 * 128;
                            float* cks = (float*)(al + LDS_X);
                            fox_scan(LOGF + (size_t)h16 * S_, cks, (float*)(al + 2 * SHM_V + 2 * SHM_K));
                            Ctx C{nullptr, cks, nullptr, 0.f};
                            Ref r0{Qh + (size_t)qb0 * 256 * 128, Kh, Vh, nullptr, Oh + (size_t)qb0 * 256 * OST, qb0 * 256, nullptr};
                            Ref r1{Qh + (size_t)qb1 * 256 * 128, Kh, Vh, nullptr, Oh + (size_t)qb1 * 256 * OST, qb1 * 256, nullptr};
                            att_prime<0>(r0, C, al, Sm); att_block<0>(r0, r1, C, al, Sm); att_block<0>(r1, r1, C, al, Sm);
                        } else {
                            const int h = h16 - 8;
                            const bf16* Qh = (const bf16*)ACT + (size_t)(3 * 8 + h) * HS; const bf16* Kh = (const bf16*)ACT + (size_t)(4 * 8 + h) * HS; const bf16* Vh = (const bf16*)ACT + (size_t)(5 * 8 + h) * HS;
                            bf16* Oh = (bf16*)AO + h16 * 128;
                            float* kmean = (float*)(al + LDS_X); float* tab = (float*)(al + LDS_TAB); unsigned* selb = (unsigned*)(al + LDS_SEL);
                            moba_gate((const bf16r*)Qh, KPART + (size_t)h * 32 * 2 * 128, ARGIN(4), h, qb0, qb1, kmean, tab, selb);
                            Ctx C{nullptr, nullptr, tab, tab[128]};
                            Ref r0{Qh + (size_t)qb0 * 256 * 128, Kh, Vh, nullptr, Oh + (size_t)qb0 * 256 * OST, qb0 * 256, selb};
                            Ref r1{Qh + (size_t)qb1 * 256 * 128, Kh, Vh, nullptr, Oh + (size_t)qb1 * 256 * OST, qb1 * 256, selb + 256};
                            att_prime<1>(r0, C, al, Sm); att_block<1>(r0, r1, C, al, Sm); att_block<1>(r1, r1, C, al, Sm);
                        }
                        asm volatile("s_waitcnt vmcnt(0)" ::: "memory"); __syncthreads();
                    }
                } else if (kind == 5) {
                    const bool isdown = (u == 3);
                    const bf16r* A = isdown ? (const bf16r*)ACT : AO;
                    const bf16r* Bw = isdown ? WB + O_WDN + (size_t)L * E_WDN : (odd ? WB + O_WOUT_O + (size_t)j * E_W2K : WB + O_WOUT_E + (size_t)j * E_W2K);
                    const float* xres = (!isdown && L == 0) ? ARGIN(0) : XF;
                    pg8::Gemm g{A, Bw, S_, 2048, isdown ? DFF : 2048}; pg8::StaticOrder So; So.init(S_, 2048, G, bx);
                    pg8::EpiResid E{xres, Z, ALPHA};
                    pg8::gemm_phase<pg8::EpiResid, pg8::StaticOrder, true, true>(ldsl, g, So, E);
                } else if (kind == 6) {
                    const int which = (u == 4) ? 1 : 0;
                    const float* gp = ARGIN(14) + (size_t)(L * 2 + which) * DM; const float* bp = ARGIN(15) + (size_t)(L * 2 + which) * DM;
                    const bool last = (L == 3 && which == 1);
                    const bool fg = (which == 1 && L == 1);
                    if (fg) load_wfT((LAS float*)ldsl, ARGIN(1) + (size_t)1 * 2048 * ABIN);
                    row_phase(gw, NGW, lane, Z, true, gp, bp, last ? args.out : XF, last ? nullptr : XB, (const LAS float*)ldsl, ARGIN(2) + 8, fg ? LOGF : nullptr);
                    __syncthreads();
                } else {
                    pg8::Gemm g{XB, WB + O_WGU + (size_t)L * E_WGU, S_, NGU, 2048}; pg8::StaticOrder So; So.init(S_, NGU, G, bx);
                    pg8::EpiSwiglu E{(bf16r*)ACT, DFF};
                    pg8::gemm_phase<pg8::EpiSwiglu, pg8::StaticOrder, true, true>(ldsl, g, So, E);
                }
              }
            }
            PH_END;
        }
    }
#undef PH_ON
#undef PH_END
}

extern "C" void kernel_launch(void* const* d_in, const int* in_sizes, int n_in, void* d_out, int out_size, void* d_ws, size_t ws_size, hipStream_t stream) {
    static int grid = 0;
    if (grid == 0) {
        if (n_in != 16 || out_size != S_ * DM || ws_size < WS_END) { fprintf(stderr, "kernel_launch: unexpected shapes (n_in %d out %d ws %zu need %zu)\n", n_in, out_size, ws_size, (size_t)WS_END); grid = -1; return; }
        int dev = 0, cus = 0, per_cu = 0;
        (void)hipGetDevice(&dev); (void)hipDeviceGetAttribute(&cus, hipDeviceAttributeMultiprocessorCount, dev);
        if (hipFuncSetAttribute((const void*)mega_fwd, hipFuncAttributeMaxDynamicSharedMemorySize, LDS_BYTES) != hipSuccess) fprintf(stderr, "kernel_launch: hipFuncSetAttribute failed\n");
        if (hipOccupancyMaxActiveBlocksPerMultiprocessor(&per_cu, (const void*)mega_fwd, 512, LDS_BYTES) != hipSuccess || per_cu < 1) { fprintf(stderr, "kernel_launch: occupancy query says %d\n", per_cu); per_cu = 1; }
        (void)hipGetLastError();
        if (cus <= 0) cus = 256;
        grid = cus;
    }
    if (grid < 0) return;
    Args a{};
    for (int i = 0; i < 16; ++i) a.in[i] = (const float*)d_in[i];
    a.out = (float*)d_out; a.ws = (unsigned char*)d_ws; a.ph_lo = 0; a.ph_hi = 1000;
    void* params[] = {&a};
    hipError_t e = hipLaunchCooperativeKernel((const void*)mega_fwd, dim3(grid), dim3(512), params, LDS_BYTES, stream);
    if (e != hipSuccess) fprintf(stderr, "kernel_launch: cooperative launch failed: %s (grid %d)\n", hipGetErrorString(e), grid);
}
```

```cpp
#include <hip/hip_runtime.h>
#include <hip/hip_cooperative_groups.h>
#include <hip/hip_bf16.h>
#include <cstdio>
#include <cstdint>
#include <cmath>
namespace pg8 {
__device__ __forceinline__ int tid_opq() { int t = threadIdx.x; asm volatile("" : "+v"(t)); return t; }
#define PG8_LAS __attribute__((address_space(3)))
typedef unsigned short bf16_t;
typedef short bf16x8 __attribute__((ext_vector_type(8)));
typedef float f32x4 __attribute__((ext_vector_type(4)));
typedef unsigned u32x4 __attribute__((ext_vector_type(4)));
constexpr int BM = 256, BK = 64, HALF = 128, HTB = HALF * BK * 2  , STAGE_BYTES = 8 * HTB, NXCD = 8, WGM = 8;

__host__ __device__ __forceinline__ int lds_byte(int r, int c) { const int st = (r >> 4) * 2 + (c >> 5), rr = r & 15, cc = c & 31, ob = rr * 64 + cc * 2; return st * 1024 + (ob ^ (((ob >> 9) & 1) << 5)); }
__host__ __device__ __forceinline__ void stage_rc(int b, int& R, int& C) { const int st = b / 1024, sb = b % 1024, swz = sb ^ (((sb >> 9) & 1) << 5); R = (st >> 1) * 16 + swz / 64; C = (st & 1) * 32 + (swz % 64) / 2; }
__host__ __device__ __forceinline__ int perm32(int rho) { const int n = rho >> 4, i = rho & 15; return 8 * (i >> 2) + 4 * n + (i & 3); }

struct Unit { int pm, pn; };
struct Gemm { const bf16_t* A; const bf16_t* Bt; int M, N, K; };

struct StaticOrder {
    int nM, nN, nwg, G, c;
    __host__ __device__ void init(int M, int N, int G_, int c_) { nM = M / BM; nN = N / BM; nwg = nM * nN; G = G_; c = c_; }
    __host__ __device__ bool next(int i, Unit& u) const {
        const long L = (long)i * G + c; if (L >= nwg) return false;
        int wgid = (int)L; { const int q = nwg / NXCD, r = nwg % NXCD, xcd = wgid % NXCD, off = wgid / NXCD; wgid = (xcd < r ? xcd * (q + 1) : r * (q + 1) + (xcd - r) * q) + off; }
        const int nig = WGM * nN, gid = wgid / nig, fm = gid * WGM, gsz = (nM - fm) < WGM ? (nM - fm) : WGM;
        u.pm = fm + ((wgid % nig) % gsz); u.pn = (wgid % nig) / gsz; return true;
    }
    __device__ __forceinline__ void a_ready(const Unit&) const {}
    __device__ __forceinline__ void done(const Unit&) const {}
};

__device__ __forceinline__ unsigned cvt_pk_bf16(float lo, float hi) { unsigned r; asm volatile("v_cvt_pk_bf16_f32 %0, %1, %2" : "=v"(r) : "v"(lo), "v"(hi)); return r; }
typedef float f32x2 __attribute__((ext_vector_type(2)));
template <class Epi, class Sched, bool ALIGN_EPI = false, bool SP2 = false>
__device__ __forceinline__ void gemm_phase(PG8_LAS unsigned char* lds, const Gemm g, const Sched& S, const Epi& E) {
    const int tid = tid_opq(), wid = __builtin_amdgcn_readfirstlane(tid >> 6), lane = tid & 63, wr = wid >> 2, wc = wid & 3, fr = lane & 15, fq = lane >> 4;
    const int K = g.K, nt = K / BK;
    unsigned voffA[2], voffB[2];
#pragma unroll
    for (int i = 0; i < 2; ++i) { int R, C; stage_rc(tid * 16 + i * 8192, R, C); const int Rb = Epi::PERM ? ((R & ~31) + perm32(R & 31)) : R;
        voffA[i] = (unsigned)(R * K + C) * 2u; voffB[i] = (unsigned)(Rb * K + C) * 2u; }
    const size_t kstep = (size_t)(BK * 2);
    const size_t hstep = (size_t)HALF * K * 2;
    const size_t tstep = 2 * hstep;
    const unsigned ldsw = (unsigned)wid * 1024u;
    const int aoff = lds_byte(wr * 64 + fr, fq * 8), boff = lds_byte(wc * 32 + fr, fq * 8);
#define PG8_SA(b, h) (((b) * 2 + (h)) * HTB)
#define PG8_SB(b, h) ((4 + (b) * 2 + (h)) * HTB)
#define PG8_STAGE(bufoff, gbase, voff) do { _Pragma("unroll") for (int _i = 0; _i < 2; ++_i) \
        __builtin_amdgcn_global_load_lds((const unsigned*)((const char*)(gbase) + (voff)[_i]), (PG8_LAS unsigned*)(lds + (bufoff) + ldsw + _i * 8192), 16, 0, 0); } while (0)
#define PG8_LDA(dst, b, h) do { _Pragma("unroll") for (int m = 0; m < 4; ++m) _Pragma("unroll") for (int k = 0; k < 2; ++k) dst[m][k] = *(const PG8_LAS bf16x8*)(lds + PG8_SA(b, h) + aoff + m * 2048 + k * 1024); } while (0)
#define PG8_LDB(dst, b, h) do { _Pragma("unroll") for (int n = 0; n < 2; ++n) _Pragma("unroll") for (int k = 0; k < 2; ++k) dst[n][k] = *(const PG8_LAS bf16x8*)(lds + PG8_SB(b, h) + boff + n * 2048 + k * 1024); } while (0)
#define PG8_MMA(ai, bj, At, Bt) do { __builtin_amdgcn_s_setprio(1); _Pragma("unroll") for (int m = 0; m < 4; ++m) _Pragma("unroll") for (int n = 0; n < 2; ++n) _Pragma("unroll") for (int k = 0; k < 2; ++k) \
        acc[ai][bj][m][n] = __builtin_amdgcn_mfma_f32_16x16x32_bf16(Bt[n][k], At[m][k], acc[ai][bj][m][n], 0, 0, 0); __builtin_amdgcn_s_setprio(0); } while (0)
#define PG8_WAIT_V(n) asm volatile("s_waitcnt vmcnt(" #n ")" ::: "memory")
#define PG8_WAIT_L(n) asm volatile("s_waitcnt lgkmcnt(" #n ")" ::: "memory")
#define PG8_BAR __builtin_amdgcn_s_barrier()
#define PG8_SCHED __builtin_amdgcn_sched_barrier(0)
    Unit cur, nxt; int ui = 0;
    if (!S.next(0, cur)) return;
    f32x4 acc[2][2][4][2];
#pragma unroll
    for (int a = 0; a < 2; ++a)
#pragma unroll
        for (int b = 0; b < 2; ++b)
#pragma unroll
            for (int m = 0; m < 4; ++m)
#pragma unroll
                for (int n = 0; n < 2; ++n) acc[a][b][m][n] = (f32x4){0.f, 0.f, 0.f, 0.f};
    bf16x8 At[4][2], B0[2][2], B1[2][2];
    const char* cA = (const char*)g.A + (size_t)cur.pm * tstep; const char* cB = (const char*)g.Bt + (size_t)cur.pn * tstep;
    S.a_ready(cur);
    if constexpr (SP2) {
        PG8_STAGE(PG8_SB(0, 0), cB, voffB); PG8_STAGE(PG8_SB(0, 1), cB + hstep, voffB); PG8_STAGE(PG8_SA(0, 0), cA, voffA); PG8_STAGE(PG8_SA(0, 1), cA + hstep, voffA);
        if (wr == 1) PG8_BAR;
        PG8_WAIT_V(2); PG8_BAR;
        PG8_STAGE(PG8_SB(1, 0), cB + kstep, voffB); PG8_STAGE(PG8_SA(1, 0), cA + kstep, voffA); PG8_STAGE(PG8_SB(1, 1), cB + hstep + kstep, voffB);
        PG8_WAIT_V(6); PG8_BAR;
    } else {
        PG8_STAGE(PG8_SB(0, 0), cB, voffB); PG8_STAGE(PG8_SA(0, 0), cA, voffA); PG8_STAGE(PG8_SB(0, 1), cB + hstep, voffB); PG8_STAGE(PG8_SA(0, 1), cA + hstep, voffA);
        if (wr == 1) PG8_BAR;
        PG8_WAIT_V(4); PG8_BAR;
        PG8_STAGE(PG8_SB(1, 0), cB + kstep, voffB); PG8_STAGE(PG8_SA(1, 0), cA + kstep, voffA); PG8_STAGE(PG8_SB(1, 1), cB + hstep + kstep, voffB);
        PG8_WAIT_V(6); PG8_BAR;
    }
    for (;;) {
        const bool has_next = S.next(ui + 1, nxt);
        const char* nA = has_next ? (const char*)g.A + (size_t)nxt.pm * tstep : cA; const char* nB = has_next ? (const char*)g.Bt + (size_t)nxt.pn * tstep : cB;
        for (int t = 0; t < nt; t += 2) {
            const bool last = (t == nt - 2);
            const char* a1 = cA + (size_t)(t + 1) * kstep;
            const char* a2 = last ? nA : cA + (size_t)(t + 2) * kstep; const char* b2 = last ? nB : cB + (size_t)(t + 2) * kstep;
            const char* a3 = a2 + kstep; const char* b3 = b2 + kstep;
            if (last && has_next) S.a_ready(nxt);
            if constexpr (SP2) {
            PG8_LDB(B0, 0, 0); PG8_LDB(B1, 0, 1); PG8_SCHED; PG8_LDA(At, 0, 0); PG8_STAGE(PG8_SA(1, 1), a1 + hstep, voffA);
            PG8_WAIT_V(8); PG8_WAIT_L(0); PG8_BAR; PG8_MMA(0, 0, At, B0); PG8_MMA(0, 1, At, B1); PG8_BAR; PG8_SCHED;
            PG8_LDA(At, 0, 1); PG8_STAGE(PG8_SB(0, 0), b2, voffB); PG8_STAGE(PG8_SB(0, 1), b2 + hstep, voffB); PG8_STAGE(PG8_SA(0, 0), a2, voffA);
            PG8_WAIT_V(8); PG8_WAIT_L(0); PG8_BAR; PG8_MMA(1, 0, At, B0); PG8_MMA(1, 1, At, B1); PG8_BAR; PG8_SCHED;
            PG8_LDB(B0, 1, 0); PG8_LDB(B1, 1, 1); PG8_SCHED; PG8_LDA(At, 1, 0); PG8_STAGE(PG8_SA(0, 1), a2 + hstep, voffA);
            PG8_WAIT_V(8); PG8_WAIT_L(0); PG8_BAR; PG8_MMA(0, 0, At, B0); PG8_MMA(0, 1, At, B1); PG8_BAR; PG8_SCHED;
            PG8_LDA(At, 1, 1); PG8_STAGE(PG8_SB(1, 0), b3, voffB); PG8_STAGE(PG8_SB(1, 1), b3 + hstep, voffB); PG8_STAGE(PG8_SA(1, 0), a3, voffA);
            PG8_WAIT_V(8); PG8_WAIT_L(0); PG8_BAR; PG8_MMA(1, 0, At, B0); PG8_MMA(1, 1, At, B1); PG8_BAR; PG8_SCHED;
            } else {
            PG8_LDB(B0, 0, 0); PG8_SCHED; PG8_LDA(At, 0, 0); PG8_STAGE(PG8_SA(1, 1), a1 + hstep, voffA);
            PG8_WAIT_L(8); PG8_BAR; PG8_WAIT_L(0); PG8_MMA(0, 0, At, B0); PG8_BAR; PG8_SCHED;
            PG8_LDB(B1, 0, 1); PG8_STAGE(PG8_SB(0, 0), b2, voffB);
            PG8_BAR; PG8_WAIT_L(0); PG8_MMA(0, 1, At, B1); PG8_BAR;
            PG8_LDA(At, 0, 1); PG8_STAGE(PG8_SA(0, 0), a2, voffA);
            PG8_BAR; PG8_WAIT_L(0); PG8_MMA(1, 0, At, B0); PG8_BAR; PG8_SCHED;
            PG8_STAGE(PG8_SB(0, 1), b2 + hstep, voffB);
            PG8_WAIT_V(6); PG8_BAR; PG8_MMA(1, 1, At, B1); PG8_BAR;
            PG8_LDB(B0, 1, 0); PG8_SCHED; PG8_LDA(At, 1, 0); PG8_STAGE(PG8_SA(0, 1), a2 + hstep, voffA);
            PG8_WAIT_L(8); PG8_BAR; PG8_WAIT_L(0); PG8_MMA(0, 0, At, B0); PG8_BAR; PG8_SCHED;
            PG8_LDB(B1, 1, 1); PG8_STAGE(PG8_SB(1, 0), b3, voffB);
            PG8_BAR; PG8_WAIT_L(0); PG8_MMA(0, 1, At, B1); PG8_BAR;
            PG8_LDA(At, 1, 1); PG8_STAGE(PG8_SA(1, 0), a3, voffA);
            PG8_BAR; PG8_WAIT_L(0); PG8_MMA(1, 0, At, B0); PG8_BAR; PG8_SCHED;
            PG8_STAGE(PG8_SB(1, 1), b3 + hstep, voffB);
            PG8_WAIT_V(6); PG8_BAR; PG8_MMA(1, 1, At, B1); PG8_BAR;
            }
        }
        if constexpr (ALIGN_EPI) { if (wr == 0) PG8_BAR; }
        if constexpr (!Epi::AFTER_DRAIN) { E(acc, cur, wr, wc, fr, fq); S.done(cur); }
        if (!has_next) break;
#pragma unroll
        for (int a = 0; a < 2; ++a)
#pragma unroll
            for (int b = 0; b < 2; ++b)
#pragma unroll
                for (int m = 0; m < 4; ++m)
#pragma unroll
                    for (int n = 0; n < 2; ++n) acc[a][b][m][n] = (f32x4){0.f, 0.f, 0.f, 0.f};
        cur = nxt; cA = nA; cB = nB; ++ui;
        if constexpr (ALIGN_EPI) { if (wr == 1) PG8_BAR; }
    }
    PG8_WAIT_V(0);
    if constexpr (!ALIGN_EPI) { if (wr == 0) PG8_BAR; }
    PG8_BAR;
    if constexpr (Epi::AFTER_DRAIN) { E.fused(acc, cur, wr, wc, fr, fq, lds, wid, lane); S.done(cur); }
#undef PG8_SA
#undef PG8_SB
#undef PG8_STAGE
#undef PG8_LDA
#undef PG8_LDB
#undef PG8_MMA
#undef PG8_WAIT_V
#undef PG8_WAIT_L
#undef PG8_BAR
#undef PG8_SCHED
}
}
namespace pg8 {
typedef unsigned u32x2e __attribute__((ext_vector_type(2)));
constexpr int SEQ = 8192;
__device__ __forceinline__ u32x4 pack8bf(const f32x4 v0, const f32x4 v1) { u32x4 w; w.x = cvt_pk_bf16(v0[0], v0[1]); w.y = cvt_pk_bf16(v0[2], v0[3]); w.z = cvt_pk_bf16(v1[0], v1[1]); w.w = cvt_pk_bf16(v1[2], v1[3]); return w; }
struct EpiPlain {
    static constexpr bool PERM = true, AFTER_DRAIN = false;
    bf16_t* O; int ldc;
    __device__ __forceinline__ void operator()(const f32x4 (&acc)[2][2][4][2], const Unit& u, int wr, int wc, int fr, int fq) const {
        const int row0 = u.pm * BM + wr * 64 + fr, col0 = u.pn * BM + wc * 32 + 8 * fq;
#pragma unroll
        for (int ai = 0; ai < 2; ++ai)
#pragma unroll
            for (int m = 0; m < 4; ++m) { bf16_t* rowp = O + (size_t)(row0 + ai * HALF + m * 16) * ldc + col0;
#pragma unroll
                for (int bj = 0; bj < 2; ++bj) *(u32x4*)(rowp + bj * HALF) = pack8bf(acc[ai][bj][m][0], acc[ai][bj][m][1]); }
    }
};
struct EpiHeads {
    static constexpr bool PERM = true, AFTER_DRAIN = false;
    bf16_t* base; int tps, nh, ksec; float* kpart;
    __device__ __forceinline__ void operator()(const f32x4 (&acc)[2][2][4][2], const Unit& u, int wr, int wc, int fr, int fq) const {
        const int sec = u.pn / tps, h0 = (u.pn % tps) * 2, row0 = u.pm * BM + wr * 64 + fr, c0 = wc * 32 + 8 * fq;
#pragma unroll
        for (int bj = 0; bj < 2; ++bj) { bf16_t* hb = base + ((size_t)(sec * nh + h0 + bj) * SEQ) * 128 + c0;
#pragma unroll
            for (int ai = 0; ai < 2; ++ai)
#pragma unroll
                for (int m = 0; m < 4; ++m) *(u32x4*)(hb + (size_t)(row0 + ai * HALF + m * 16) * 128) = pack8bf(acc[ai][bj][m][0], acc[ai][bj][m][1]); }
        if (sec == ksec) {
#pragma unroll
            for (int bj = 0; bj < 2; ++bj)
#pragma unroll
                for (int n = 0; n < 2; ++n) { f32x4 s = (f32x4){0.f, 0.f, 0.f, 0.f};
#pragma unroll
                    for (int ai = 0; ai < 2; ++ai)
#pragma unroll
                        for (int m = 0; m < 4; ++m) s += acc[ai][bj][m][n];
#pragma unroll
                    for (int o = 1; o < 16; o <<= 1) { s[0] += __shfl_xor(s[0], o); s[1] += __shfl_xor(s[1], o); s[2] += __shfl_xor(s[2], o); s[3] += __shfl_xor(s[3], o); }
                    if (fr == 0) *(f32x4*)(kpart + ((size_t)((h0 + bj) * 32 + u.pm) * 2 + wr) * 128 + c0 + 4 * n) = s; }
        }
    }
};
struct EpiSwiglu {
    static constexpr bool PERM = true, AFTER_DRAIN = false;
    bf16_t* O; int ldc;
    __device__ __forceinline__ void operator()(const f32x4 (&acc)[2][2][4][2], const Unit& u, int wr, int wc, int fr, int fq) const {
        const int row0 = u.pm * BM + wr * 64 + fr, col0 = u.pn * HALF + wc * 32 + 8 * fq;
#pragma unroll
        for (int ai = 0; ai < 2; ++ai)
#pragma unroll
            for (int m = 0; m < 4; ++m) { f32x4 r[2];
#pragma unroll
                for (int n = 0; n < 2; ++n) { const f32x4 g = acc[ai][0][m][n], uu = acc[ai][1][m][n];
#pragma unroll
                    for (int j = 0; j < 4; ++j) r[n][j] = g[j] * __builtin_amdgcn_rcpf(1.f + __expf(-g[j])) * uu[j]; }
                *(u32x4*)(O + (size_t)(row0 + ai * HALF + m * 16) * ldc + col0) = pack8bf(r[0], r[1]); }
    }
};
struct EpiResid {
    static constexpr bool PERM = false, AFTER_DRAIN = false;
    const float* xres; float* z; float alpha;
    __device__ __forceinline__ void operator()(const f32x4 (&acc)[2][2][4][2], const Unit& u, int wr, int wc, int fr, int fq) const {
        const int row0 = u.pm * BM + wr * 64 + fr, col0 = u.pn * BM + wc * 32 + 4 * fq;
#pragma unroll
        for (int ai = 0; ai < 2; ++ai)
#pragma unroll
            for (int m = 0; m < 4; ++m) { const size_t off = (size_t)(row0 + ai * HALF + m * 16) * 2048 + col0;
#pragma unroll
                for (int bj = 0; bj < 2; ++bj)
#pragma unroll
                    for (int n = 0; n < 2; ++n) { const f32x4 xv = *(const f32x4*)(xres + off + bj * HALF + n * 16);
                        *(f32x4*)(z + off + bj * HALF + n * 16) = xv * alpha + acc[ai][bj][m][n]; } }
    }
};
struct EpiQup {
    static constexpr bool PERM = true, AFTER_DRAIN = false;
    bf16_t* QN; bf16_t* QR; const float* cosT; const float* sinT;
    __device__ __forceinline__ void operator()(const f32x4 (&acc)[2][2][4][2], const Unit& u, int wr, int wc, int fr, int fq) const {
        const int row0 = u.pm * BM + wr * 64 + fr;
        if (u.pn < 8) {
#pragma unroll
            for (int bj = 0; bj < 2; ++bj) { bf16_t* hb = QN + ((size_t)(u.pn * 2 + bj) * SEQ) * 128 + wc * 32 + 8 * fq;
#pragma unroll
                for (int ai = 0; ai < 2; ++ai)
#pragma unroll
                    for (int m = 0; m < 4; ++m) *(u32x4*)(hb + (size_t)(row0 + ai * HALF + m * 16) * 128) = pack8bf(acc[ai][bj][m][0], acc[ai][bj][m][1]); }
        } else {
            const int head = (u.pn - 8) * 4 + wc;
#pragma unroll
            for (int ai = 0; ai < 2; ++ai)
#pragma unroll
                for (int m = 0; m < 4; ++m) { const int row = row0 + ai * HALF + m * 16; f32x4 o1[2], o2[2];
#pragma unroll
                    for (int n = 0; n < 2; ++n) { const f32x4 c = *(const f32x4*)(cosT + (size_t)row * 32 + 8 * fq + 4 * n), s = *(const f32x4*)(sinT + (size_t)row * 32 + 8 * fq + 4 * n);
                        const f32x4 x1 = acc[ai][0][m][n], x2 = acc[ai][1][m][n]; o1[n] = x1 * c - x2 * s; o2[n] = x1 * s + x2 * c; }
                    bf16_t* dst = QR + ((size_t)head * SEQ + row) * 64 + 8 * fq;
                    *(u32x4*)dst = pack8bf(o1[0], o1[1]); *(u32x4*)(dst + 32) = pack8bf(o2[0], o2[1]); }
        }
    }
};
struct EpiKVup {
    static constexpr bool PERM = true, AFTER_DRAIN = false;
    bf16_t* KN; bf16_t* V;
    __device__ __forceinline__ void operator()(const f32x4 (&acc)[2][2][4][2], const Unit& u, int wr, int wc, int fr, int fq) const {
        const int row0 = u.pm * BM + wr * 64 + fr;
#pragma unroll
        for (int bj = 0; bj < 2; ++bj) { bf16_t* hb = (bj ? V : KN) + ((size_t)u.pn * SEQ) * 128 + wc * 32 + 8 * fq;
#pragma unroll
            for (int ai = 0; ai < 2; ++ai)
#pragma unroll
                for (int m = 0; m < 4; ++m) *(u32x4*)(hb + (size_t)(row0 + ai * HALF + m * 16) * 128) = pack8bf(acc[ai][bj][m][0], acc[ai][bj][m][1]); }
    }
};
}
namespace att {
using bf16 = __hip_bfloat16;
constexpr float THR = 8.f; constexpr int NW = 8, QBLK = 32, KVBLK = 64, QB = 256, D = 128; constexpr int SHM_V = KVBLK * D * 2, SHM_K = KVBLK * D * 2;
typedef short bf16x8 __attribute__((ext_vector_type(8)));
typedef short s16x4 __attribute__((ext_vector_type(4)));
typedef float f32x16 __attribute__((ext_vector_type(16)));
typedef float f32x4 __attribute__((ext_vector_type(4)));
typedef unsigned u32x4 __attribute__((ext_vector_type(4)));
template <class A, class Bt> struct same_t { static constexpr bool v = false; };
template <class A> struct same_t<A, A> { static constexpr bool v = true; };

#define KSWZ(row, colB) ((row) * 256 + ((colB) ^ (((row) & 7) << 4)))
#define SBAR() __builtin_amdgcn_sched_barrier(0)
__device__ __forceinline__ int v_st(int k, int c) { const int kk = (k & ~0xC) | ((k & 4) << 1) | ((k & 8) >> 1); return ((kk >> 3) * 4 + (c >> 5)) * 512 + ((kk & 7) * 32 + (c & 31)) * 2; }
__device__ __forceinline__ int v_rd_base(int lane) { return ((lane & 3) << 3) | (((lane >> 2) & 3) << 6) | (((lane >> 4) & 1) << 5) | (((lane >> 5) & 1) << 8); }
constexpr int v_rd_off(int d0, int ks, int half) { return d0 * 512 + ks * 4096 + half * 2048; }
__device__ __forceinline__ int crow(int r, int hi) { return (r & 3) + 8 * (r >> 2) + 4 * hi; }
__device__ __forceinline__ unsigned cvtpk(float lo, float hi) {
    unsigned r; asm volatile("v_cvt_pk_bf16_f32 %0, %1, %2" : "=v"(r) : "v"(lo), "v"(hi)); return r;
}
__device__ __forceinline__ bf16x8 pack8(f32x4 a, f32x4 b) {
    u32x4 w = {cvtpk(a[0], a[1]), cvtpk(a[2], a[3]), cvtpk(b[0], b[1]), cvtpk(b[2], b[3])};
    return *reinterpret_cast<bf16x8*>(&w);
}
template <class T> __device__ __forceinline__ bf16x8 load8(const T* p) {
    if constexpr (same_t<T, float>::v) { return pack8(*(const f32x4*)p, *(const f32x4*)(p + 4)); }
    else { return *reinterpret_cast<const bf16x8*>(p); }
}
__device__ __forceinline__ void mask_tile(f32x16& p0, f32x16& p1, int dq, unsigned W) {
    const float NEG = -__builtin_inff();
#pragma unroll
    for (int r = 0; r < 16; ++r) {
        const int c = (r & 3) + 8 * (r >> 2);
        if ((unsigned)(dq - c) >= W) p0[r] = NEG;
        if ((unsigned)(dq - c - 32) >= W) p1[r] = NEG;
    }
}
template <int MLA> __device__ __forceinline__ void partialSM(f32x16& p0, f32x16& p1, float& m_reg, float& mn, float& alpha) {
    constexpr float SCALE = MLA ? 0.07216878364870322f : 0.08838834764831845f;
    float pmax = p0[0]; for (int r = 1; r < 16; ++r) pmax = fmaxf(pmax, p0[r]); for (int r = 0; r < 16; ++r) pmax = fmaxf(pmax, p1[r]);
    { auto rr = __builtin_amdgcn_permlane32_swap(__float_as_uint(pmax), __float_as_uint(pmax), false, false);
      pmax = fmaxf(__uint_as_float(rr[0]), __uint_as_float(rr[1])); }
    constexpr float C2 = 1.4426950408889634f * SCALE;
    if (__builtin_expect(__all((pmax - m_reg) * SCALE <= THR), 1)) { mn = m_reg; alpha = 1.f; }
    else { mn = fmaxf(m_reg, pmax); alpha = __builtin_amdgcn_exp2f((m_reg - mn) * C2); m_reg = mn; }
    const float mnL = -mn * C2;
    for (int r = 0; r < 16; ++r) p0[r] = fmaf(p0[r], C2, mnL); for (int r = 0; r < 16; ++r) p1[r] = fmaf(p1[r], C2, mnL);
    for (int r = 0; r < 16; ++r) p0[r] = __builtin_amdgcn_exp2f(p0[r]);
}
__device__ __forceinline__ void finishSM(f32x16& p0, f32x16& p1, float alpha, float& l_reg, bf16x8& pa0, bf16x8& pa1, bf16x8& pa2, bf16x8& pa3) {
    for (int r = 0; r < 16; ++r) p1[r] = __builtin_amdgcn_exp2f(p1[r]);
    float ps = 0; for (int r = 0; r < 16; ++r) ps += p0[r]; for (int r = 0; r < 16; ++r) ps += p1[r];
    { auto rr = __builtin_amdgcn_permlane32_swap(__float_as_uint(ps), __float_as_uint(ps), false, false);
      ps = __uint_as_float(rr[0]) + __uint_as_float(rr[1]); }
    l_reg = l_reg * alpha + ps;
#define PK4(P, B_, OUT) do { unsigned a0 = cvtpk(P[B_+0], P[B_+1]), a1 = cvtpk(P[B_+2], P[B_+3]);                          \
        unsigned b0 = cvtpk(P[B_+4], P[B_+5]), b1 = cvtpk(P[B_+6], P[B_+7]);                                             \
        auto r0 = __builtin_amdgcn_permlane32_swap(a0, b0, false, false); auto r1 = __builtin_amdgcn_permlane32_swap(a1, b1, false, false); \
        u32x4 w = {r0[0], r1[0], r0[1], r1[1]}; OUT = *reinterpret_cast<bf16x8*>(&w); } while (0)
    PK4(p0, 0, pa0); PK4(p0, 8, pa1); PK4(p1, 0, pa2); PK4(p1, 8, pa3);
#undef PK4
}
template <int KB, bool SK>
__device__ __forceinline__ void qkt(f32x16& p0, f32x16& p1, const char* K_lds, int r32, int hi, const bf16x8* qr, bool act) {
    if (SK && !act) { const float NEG = -__builtin_inff();
#pragma unroll
        for (int r = 0; r < 16; ++r) { p0[r] = NEG; p1[r] = NEG; } return; }
    p0 = f32x16{}; p1 = f32x16{};
    const char* kb[4];
#pragma unroll
    for (int dd = 0; dd < 4; ++dd) kb[dd] = K_lds + KB * SHM_K + KSWZ(r32, (dd * 16 + hi * 8) * 2);
#pragma unroll
    for (int d0 = 0; d0 < 8; ++d0) { const char* a = kb[d0 & 3] + (d0 >> 2) * 128;
        bf16x8 b0 = *reinterpret_cast<const bf16x8*>(a);
        bf16x8 b1 = *reinterpret_cast<const bf16x8*>(a + 32 * 256);
        p0 = __builtin_amdgcn_mfma_f32_32x32x16_bf16(b0, qr[d0], p0, 0, 0, 0);
        p1 = __builtin_amdgcn_mfma_f32_32x32x16_bf16(b1, qr[d0], p1, 0, 0, 0); }
}
template <int VB, bool SK>
__device__ __forceinline__ void pv_tile(f32x16* o, int vb0, bf16x8 pa0, bf16x8 pa1, bf16x8 pa2, bf16x8 pa3, bool act) {
    if (SK && !act) return;
#define TRRD(dst, off) asm volatile("ds_read_b64_tr_b16 %0, %1 offset:%2" : "=&v"(dst) : "v"(vb0), "i"(off) : "memory")
#define PV_D0(d0) do { s16x4 l0, l1, l2, l3, h0, h1, h2, h3; constexpr int b_ = VB * SHM_V + v_rd_off(d0, 0, 0);     \
        TRRD(l0, b_); TRRD(h0, b_ + 2048); TRRD(l1, b_ + 4096); TRRD(h1, b_ + 6144); TRRD(l2, b_ + 8192); TRRD(h2, b_ + 10240); TRRD(l3, b_ + 12288); TRRD(h3, b_ + 14336); \
        asm volatile("s_waitcnt lgkmcnt(0)" ::: "memory"); SBAR();                 \
        o[d0] = __builtin_amdgcn_mfma_f32_32x32x16_bf16(pa0, (bf16x8){l0[0], l0[1], l0[2], l0[3], h0[0], h0[1], h0[2], h0[3]}, o[d0], 0, 0, 0);   \
        o[d0] = __builtin_amdgcn_mfma_f32_32x32x16_bf16(pa1, (bf16x8){l1[0], l1[1], l1[2], l1[3], h1[0], h1[1], h1[2], h1[3]}, o[d0], 0, 0, 0);   \
        o[d0] = __builtin_amdgcn_mfma_f32_32x32x16_bf16(pa2, (bf16x8){l2[0], l2[1], l2[2], l2[3], h2[0], h2[1], h2[2], h2[3]}, o[d0], 0, 0, 0);   \
        o[d0] = __builtin_amdgcn_mfma_f32_32x32x16_bf16(pa3, (bf16x8){l3[0], l3[1], l3[2], l3[3], h3[0], h3[1], h3[2], h3[3]}, o[d0], 0, 0, 0); } while (0)
    PV_D0(0); PV_D0(1); PV_D0(2); PV_D0(3);
#undef PV_D0
#undef TRRD
}
struct Ref { const bf16* Q; const bf16* K; const bf16* V; const bf16* Q2; bf16* O; int P0; const unsigned* selb; };
struct Ctx { const bf16* K2; const float* cks; const float* tab; float b31; };
struct Seam { bf16x8 qr[4]; bf16x8 st_v0, st_v1, st_k0, st_k1, st_r; };
constexpr int OST = 2048;
constexpr int SHM_R = 64 * 64 * 2;
constexpr int LDS_R = 2 * SHM_V + 2 * SHM_K + NW * 64 * 4;
constexpr int LDS_X = LDS_R + 2 * SHM_R;
constexpr int LDS_TAB = LDS_X + 32768;
constexpr int LDS_SEL = LDS_TAB + 1024;
constexpr int LDS_QH = LDS_SEL + 2048;
constexpr int LDS_ATT_END = LDS_QH + 32768;
#define RSWZ(row, chunk) ((row) * 128 + ((((chunk) ^ ((row) >> 1)) & 7) << 4))
template <int KB>
__device__ __forceinline__ void qkt_rope(f32x16& p0, f32x16& p1, const char* R_lds, int r32, int hi, const char* q2l) {
#pragma unroll
    for (int d0 = 0; d0 < 4; ++d0) { const char* a = R_lds + KB * SHM_R + RSWZ(r32, d0 * 2 + hi);
        bf16x8 b0 = *reinterpret_cast<const bf16x8*>(a);
        bf16x8 b1 = *reinterpret_cast<const bf16x8*>(a + 32 * 128);
        const bf16x8 qf = *reinterpret_cast<const bf16x8*>(q2l + d0 * 1024);
        p0 = __builtin_amdgcn_mfma_f32_32x32x16_bf16(b0, qf, p0, 0, 0, 0);
        p1 = __builtin_amdgcn_mfma_f32_32x32x16_bf16(b1, qf, p1, 0, 0, 0); }
}
template <int KB>
__device__ __forceinline__ void qkt_mix(f32x16& p0, f32x16& p1, const char* K_lds, int r32, int hi, const bf16x8* qr, const char* qhl) {
    p0 = f32x16{}; p1 = f32x16{};
    const char* kb[4];
#pragma unroll
    for (int dd = 0; dd < 4; ++dd) kb[dd] = K_lds + KB * SHM_K + KSWZ(r32, (dd * 16 + hi * 8) * 2);
#pragma unroll
    for (int d0 = 0; d0 < 8; ++d0) { const char* a = kb[d0 & 3] + (d0 >> 2) * 128;
        bf16x8 b0 = *reinterpret_cast<const bf16x8*>(a);
        bf16x8 b1 = *reinterpret_cast<const bf16x8*>(a + 32 * 256);
        bf16x8 qf; if (d0 < 4) qf = qr[d0]; else qf = *reinterpret_cast<const bf16x8*>(qhl + (d0 - 4) * 1024);
        p0 = __builtin_amdgcn_mfma_f32_32x32x16_bf16(b0, qf, p0, 0, 0, 0);
        p1 = __builtin_amdgcn_mfma_f32_32x32x16_bf16(b1, qf, p1, 0, 0, 0); }
}
template <int MODE>
__device__ __forceinline__ void bias_tile(f32x16& p0, f32x16& p1, const Ctx& C, int kb, int qlo, int r32, int hi, float cqs, unsigned selbits) {
    if constexpr (MODE == 0) {
        const float* ck = C.cks + kb + 4 * hi;
#pragma unroll
        for (int j = 0; j < 4; ++j) { const f32x4 a = *(const f32x4*)(ck + 8 * j), b = *(const f32x4*)(ck + 32 + 8 * j);
#pragma unroll
            for (int i = 0; i < 4; ++i) { p0[4 * j + i] += cqs - a[i]; p1[4 * j + i] += cqs - b[i]; } }
    } else if constexpr (MODE == 1) {
        const bool sel = (selbits >> (kb >> 8)) & 1u;
        if (qlo - (kb + 63) >= 128) {
            const float bb = C.b31;
#pragma unroll
            for (int r = 0; r < 16; ++r) { p0[r] += bb; p1[r] += bb; }
        } else {
            const int dq = qlo + r32 - kb - 4 * hi;
#pragma unroll
            for (int r = 0; r < 16; ++r) { const int c = (r & 3) + 8 * (r >> 2);
                int r0 = dq - c, r1 = dq - c - 32; r0 = r0 < 0 ? 0 : (r0 > 128 ? 128 : r0); r1 = r1 < 0 ? 0 : (r1 > 128 ? 128 : r1);
                p0[r] += C.tab[r0]; p1[r] += C.tab[r1]; }
        }
        if (!sel) { const float NEG = -__builtin_inff();
#pragma unroll
            for (int r = 0; r < 16; ++r) { p0[r] = NEG; p1[r] = NEG; } }
    }
}
#define ROW(p, k0, rr) ((p) + (size_t)((k0) + (rr)) * D + sc)
#define VMW() asm volatile("s_waitcnt vmcnt(0)" ::: "memory")
#define VMWN(n) asm volatile("s_waitcnt vmcnt(%0)" :: "i"(n) : "memory")
#define RLOAD(k0) do { if constexpr (MODE == 2) S.st_r = *reinterpret_cast<const bf16x8*>(C.K2 + (size_t)((k0) + (tid >> 3)) * 64 + (tid & 7) * 8); } while (0)
#define SLOAD_H(Kp, Vp, k0) do { S.st_v0 = load8<bf16>(ROW(Vp, k0, sr)); S.st_v1 = load8<bf16>(ROW(Vp, k0, 32 + sr));              \
                         S.st_k0 = load8<bf16>(ROW(Kp, k0, sr)); S.st_k1 = load8<bf16>(ROW(Kp, k0, 32 + sr)); RLOAD(k0); } while (0)
#define SWRITE_HK(bf) do { *(bf16x8*)(K_lds + (bf) * SHM_K + kws) = S.st_k0; *(bf16x8*)(K_lds + (bf) * SHM_K + kws + 32 * 256) = S.st_k1; \
                           if constexpr (MODE == 2) *(bf16x8*)(R_lds + (bf) * SHM_R + rws) = S.st_r; } while (0)
#define SWRITE_HV(bf) do { *(bf16x8*)(V_lds + (bf) * SHM_V + vst0) = S.st_v0; *(bf16x8*)(V_lds + (bf) * SHM_V + vst1) = S.st_v1; } while (0)
#define SWRITE_H(bf) do { SWRITE_HV(bf); SWRITE_HK(bf); } while (0)
template <int MODE>
__device__ __forceinline__ void att_prime(const Ref& cur, const Ctx& C, char* lds, Seam& S) {
    const int tid = pg8::tid_opq(), wid = __builtin_amdgcn_readfirstlane(tid >> 6), lane = tid & 63, r32 = lane & 31, hi = lane >> 5;
    const int sr = tid >> 4, sc = (tid & 15) * 8, kws = KSWZ(sr, sc * 2), rws = RSWZ(tid >> 3, tid & 7); char* K_lds = lds + 2 * SHM_V; char* R_lds = lds + LDS_R;
#pragma unroll
    for (int d0 = 0; d0 < 4; ++d0) S.qr[d0] = load8<bf16>(cur.Q + (size_t)(wid * QBLK + r32) * D + d0 * 16 + hi * 8);
    SLOAD_H(cur.K, cur.V, 0); VMW(); SWRITE_HK(0);
    __syncthreads();
}
template <int MODE>
__device__ __forceinline__ void att_block(const Ref& cur, const Ref& nxt, const Ctx& C, char* lds, Seam& S) {
    constexpr int MLA = (MODE == 2) ? 1 : 0;
    constexpr bool SK = false;
    constexpr int W = 0x7fffffff;
    const int tid = pg8::tid_opq(), wid = __builtin_amdgcn_readfirstlane(tid >> 6), lane = tid & 63, r32 = lane & 31, hi = lane >> 5;
    const int NT = cur.P0 / KVBLK + 4;
    const int qlo = cur.P0 + wid * QBLK, qm = qlo + r32 - 4 * hi;
    char* V_lds = lds; char* K_lds = lds + 2 * SHM_V; char* R_lds = lds + LDS_R;
    float* ws = (float*)(lds + 2 * SHM_V + 2 * SHM_K) + wid * 64; float* li_l = ws, * al_l = ws + 32;
    float m_reg = -1e30f, l_reg = 0; f32x16 o[4] = {};
    const int sr = tid >> 4, sc = (tid & 15) * 8, vst0 = v_st(sr, sc), vst1 = v_st(32 + sr, sc), kws = KSWZ(sr, sc * 2), rws = RSWZ(tid >> 3, tid & 7);
    const int vb0 = (int)(uintptr_t)V_lds + v_rd_base(lane);
    const bf16* Kh = cur.K; const bf16* Vh = cur.V;
    float cqs = 0.f; unsigned selbits = 0u;
    if constexpr (MODE == 0) cqs = C.cks[qlo + r32];
    if constexpr (MODE == 1) selbits = cur.selb[wid * QBLK + r32];
#define RESC(a) do { if (__any((a) < 1.f)) { if (hi == 0) al_l[r32] = (a); asm volatile("s_waitcnt lgkmcnt(0)" ::: "memory");              \
                     for (int d_ = 0; d_ < 4; ++d_) for (int r = 0; r < 16; ++r) o[d_][r] *= al_l[crow(r, hi)]; } } while (0)
#define KBASE(t) ((t) * KVBLK)
#define MASKT(P0_, P1_, t) do { const int kb_ = KBASE(t); bias_tile<MODE>(P0_, P1_, C, kb_, qlo, r32, hi, cqs, selbits); if (kb_ + KVBLK - 1 > qlo) mask_tile(P0_, P1_, qm - kb_, (unsigned)W); } while (0)
#define QKT(KB, PX0, PX1) do { qkt_mix<KB>(PX0, PX1, K_lds, r32, hi, S.qr, qhl); if constexpr (MODE == 2) qkt_rope<KB>(PX0, PX1, R_lds, r32, hi, q2l); } while (0)
    constexpr int NQL = 4;
#define SEAM_K0() do { VMWN(NQL); SWRITE_HK(0); SBAR(); } while (0)
    f32x16 pA0, pA1, pB0, pB1; float mnA, mnB, alA, alB; bf16x8 pa0, pa1, pa2, pa3;
    char* q2l = lds + LDS_X + wid * 4096 + lane * 16;
    char* qhl = lds + LDS_QH + wid * 4096 + lane * 16;
#pragma unroll
    for (int d0 = 4; d0 < 8; ++d0) *(bf16x8*)(qhl + (d0 - 4) * 1024) = load8<bf16>(cur.Q + (size_t)(wid * QBLK + r32) * D + d0 * 16 + hi * 8);
    if constexpr (MODE == 2) {
#pragma unroll
        for (int d0 = 0; d0 < 4; ++d0) *(bf16x8*)(q2l + d0 * 1024) = load8<bf16>(cur.Q2 + (size_t)(wid * QBLK + r32) * 64 + d0 * 16 + hi * 8); }
    SWRITE_HV(0); SBAR();
    if (NT > 1) { SLOAD_H(Kh, Vh, KBASE(1)); }
    SBAR(); QKT(0, pA0, pA1);
    MASKT(pA0, pA1, 0); partialSM<MLA>(pA0, pA1, m_reg, mnA, alA);
    if (NT > 1) { VMW(); SWRITE_H(1); }
    __syncthreads();
#define HALF_STEP(PX0, PX1, mnX, alX, PY0, PY1, alY, t, KB, VB, SB) do {                                                      \
        SBAR(); QKT(KB, PX0, PX1);                                                                                            \
        finishSM(PY0, PY1, alY, l_reg, pa0, pa1, pa2, pa3); SBAR();                                                           \
        if ((t) + 1 < NT) { SLOAD_H(Kh, Vh, KBASE((t) + 1)); SBAR(); }                                                        \
        pv_tile<VB, SK>(o, vb0, pa0, pa1, pa2, pa3, true); MASKT(PX0, PX1, (t)); partialSM<MLA>(PX0, PX1, m_reg, mnX, alX);   \
        __syncthreads();                                                                                                      \
        if ((t) + 1 < NT) { VMW(); SWRITE_H(SB); }                                                                            \
        RESC(alX); __syncthreads(); } while (0)
    for (int t = 1; t + 1 < NT; t += 2) {
        HALF_STEP(pB0, pB1, mnB, alB, pA0, pA1, alA, t, 1, 0, 0);
        HALF_STEP(pA0, pA1, mnA, alA, pB0, pB1, alB, t + 1, 0, 1, 1);
    }
    const bool even = (NT & 1) == 0;
    if (even) { SBAR(); QKT(1, pB0, pB1); SBAR(); }
    { SLOAD_H(nxt.K, nxt.V, 0); SBAR();
#pragma unroll
      for (int d0 = 0; d0 < 4; ++d0) S.qr[d0] = load8<bf16>(nxt.Q + (size_t)(wid * QBLK + r32) * D + d0 * 16 + hi * 8);
    }
    SBAR();
    finishSM(pA0, pA1, alA, l_reg, pa0, pa1, pa2, pa3); SBAR();
    pv_tile<0, SK>(o, vb0, pa0, pa1, pa2, pa3, true);
    if (even) { MASKT(pB0, pB1, NT - 1); partialSM<MLA>(pB0, pB1, m_reg, mnB, alB); __syncthreads(); RESC(alB);
        finishSM(pB0, pB1, alB, l_reg, pa0, pa1, pa2, pa3); SBAR(); pv_tile<1, SK>(o, vb0, pa0, pa1, pa2, pa3, true); }
    SBAR(); SEAM_K0();
    if (hi == 0) li_l[r32] = l_reg; asm volatile("s_waitcnt lgkmcnt(0)" ::: "memory");
    float rli[16];
#pragma unroll
    for (int r = 0; r < 16; ++r) rli[r] = __builtin_amdgcn_rcpf(li_l[crow(r, hi)]);
    bf16* Ow = cur.O + (size_t)(wid * QBLK) * OST;
#pragma unroll
    for (int r = 0; r < 16; ++r) { const int orow = crow(r, hi);
#pragma unroll
        for (int d0 = 0; d0 < 4; ++d0) { const float v = o[d0][r] * rli[r];
            const float vn = __shfl_xor(v, 1);
            if ((r32 & 1) == 0) *(unsigned*)(Ow + (size_t)orow * OST + d0 * 32 + r32) = cvtpk(v, vn); } }
    __syncthreads();
#undef RESC
#undef KBASE
#undef MASKT
#undef QKT
#undef SEAM_K0
#undef HALF_STEP
}
#undef ROW
#undef VMW
#undef VMWN
#undef RLOAD
#undef SLOAD_H
#undef SWRITE_HK
#undef SWRITE_HV
#undef SWRITE_H
#undef SBAR
#undef KSWZ
}
namespace cg = cooperative_groups;
#define LAS __attribute__((address_space(3)))
typedef unsigned short bf16r;
typedef unsigned v4u __attribute__((ext_vector_type(4)));
typedef float f32x4 __attribute__((ext_vector_type(4)));
constexpr int S_ = 8192, DM = 2048, DFF = 5632, NGU = 11264, ABIN = 6152, MLAIN = 1088, MLAINP = 1280;
constexpr float ALPHA = 1.681792830507429f;
constexpr float LN_EPS = 1e-5f, RMS_EPS = 1e-6f;
constexpr int LDS_BYTES = 155648;
constexpr size_t MiB = 1u << 20;
constexpr size_t E_WIN_E = (size_t)6144 * 2048, E_W2K = (size_t)2048 * 2048, E_WIN_O = (size_t)MLAINP * 2048, E_WUQ = (size_t)3072 * 512, E_WUKV = (size_t)4096 * 512,
                 E_WGU = (size_t)NGU * 2048, E_WDN = (size_t)2048 * DFF;
constexpr size_t O_WIN_E = 0, O_WOUT_E = O_WIN_E + 2 * E_WIN_E, O_WIN_O = O_WOUT_E + 2 * E_W2K, O_WUQ = O_WIN_O + 2 * E_WIN_O, O_WUKV = O_WUQ + 2 * E_WUQ,
                 O_WOUT_O = O_WUKV + 2 * E_WUKV, O_WGU = O_WOUT_O + 2 * E_W2K, O_WDN = O_WGU + 4 * E_WGU, O_WEND = O_WDN + 4 * E_WDN;
constexpr size_t WS_W = 0;
constexpr size_t WS_XF = ((O_WEND * 2 + MiB - 1) / MiB) * MiB;
constexpr size_t WS_XB = WS_XF + 64 * MiB;
constexpr size_t WS_Z = WS_XB + 32 * MiB;
constexpr size_t WS_AO = WS_Z + 64 * MiB;
constexpr size_t WS_ACT = WS_AO + 32 * MiB;
constexpr size_t WS_SMALL = WS_ACT + 160 * MiB;
constexpr size_t WS_COS = WS_SMALL, WS_SIN = WS_COS + 1 * MiB, WS_LOGF = WS_SIN + 1 * MiB, WS_KPART = WS_LOGF + 1 * MiB, WS_BAR = WS_KPART + 512 * 1024, WS_END = WS_KPART + 1 * MiB;
constexpr size_t A_HM = 0, A_CQN = 20 * MiB, A_CKVN = 28 * MiB, A_KR = 36 * MiB, A_QN = 40 * MiB, A_QR = 72 * MiB, A_KN = 88 * MiB, A_V = 120 * MiB;

struct Args { const float* in[16]; float* out; unsigned char* ws; int ph_lo, ph_hi; };

__device__ __forceinline__ unsigned f2bf(float f) { unsigned u = __builtin_bit_cast(unsigned, f); return (u + 0x7fffu + ((u >> 16) & 1u)) >> 16; }
__device__ __forceinline__ unsigned pk2(float lo, float hi) { return f2bf(lo) | (f2bf(hi) << 16); }
__device__ __forceinline__ float bf2f(unsigned short b) { return __builtin_bit_cast(float, (unsigned)b << 16); }
__device__ __forceinline__ float wave_sum(float v) {
#pragma unroll
    for (int o = 1; o < 64; o <<= 1) v += __shfl_xor(v, o);
    return v;
}
#define LDS_WAIT() asm volatile("s_waitcnt lgkmcnt(0)" ::: "memory")

__device__ __forceinline__ int map_row(int mode, int n) {
    switch (mode) {
        case 1: return n < 3072 ? n : (n < 3080 ? -1 : n - 8);
        case 2: { const int h = n / 192, d = n % 192; if (d < 128) return h * 128 + d; const int r = d - 128; return 2048 + (h >> 2) * 256 + (r >> 5) * 128 + (h & 3) * 32 + (r & 31); }
        case 3: return (n >> 7) * 256 + (n & 127);
        case 4: return (n >> 7) * 256 + 128 + (n & 127);
        default: return n;
    }
}
__device__ __forceinline__ void transpose_item(const float* W, int K, int N, bf16r* WT, int mode, LAS float* scr, int item, int lane) {
    const int nblk = (N + 63) >> 6, kb = item / nblk, nb = item - kb * nblk, k0 = 64 * kb, n0 = 64 * nb;
    const int c4 = (lane & 15) * 4, r0 = lane >> 4; const bool okn = n0 + c4 < N;
    const float* src = W + (size_t)(k0 + r0) * N + n0 + c4;
    f32x4 v[16];
#pragma unroll
    for (int i = 0; i < 16; ++i) v[i] = okn ? *(const f32x4*)(src + (size_t)(4 * i) * N) : (f32x4){0.f, 0.f, 0.f, 0.f};
#pragma unroll
    for (int i = 0; i < 16; ++i) { const int kk = 4 * i + r0;
        scr[(c4 + 0) * 65 + kk] = v[i].x; scr[(c4 + 1) * 65 + kk] = v[i].y; scr[(c4 + 2) * 65 + kk] = v[i].z; scr[(c4 + 3) * 65 + kk] = v[i].w; }
    LDS_WAIT(); asm volatile("" ::: "memory");
    const int c = lane & 7;
#pragma unroll
    for (int j = 0; j < 8; ++j) { const int n = (lane >> 3) + 8 * j; const LAS float* s = scr + n * 65 + 8 * c;
        v4u o; o.x = pk2(s[0], s[1]); o.y = pk2(s[2], s[3]); o.z = pk2(s[4], s[5]); o.w = pk2(s[6], s[7]);
        const int gn = n0 + n; const int dr = gn < N ? map_row(mode, gn) : -1;
        if (dr >= 0) *(v4u*)(WT + (size_t)dr * K + k0 + 8 * c) = o; }
    LDS_WAIT(); asm volatile("" ::: "memory");
}
struct WDesc { int in_idx; unsigned src_off; int K, N, mode; unsigned dst_off; int nitems; };
#define WD(ii, so, K_, N_, md, dof) { ii, (unsigned)(so), K_, N_, md, (unsigned)(dof), ((K_) / 64) * (((N_) + 63) / 64) }
__constant__ WDesc g_wdesc[24] = {
    WD(1, 0, 2048, ABIN, 1, O_WIN_E), WD(1, (size_t)2048 * ABIN, 2048, ABIN, 1, O_WIN_E + E_WIN_E),
    WD(3, 0, 2048, 2048, 0, O_WOUT_E), WD(3, E_W2K, 2048, 2048, 0, O_WOUT_E + E_W2K),
    WD(5, 0, 2048, MLAIN, 0, O_WIN_O), WD(5, (size_t)2048 * MLAIN, 2048, MLAIN, 0, O_WIN_O + E_WIN_O),
    WD(8, 0, 512, 3072, 2, O_WUQ), WD(8, E_WUQ, 512, 3072, 2, O_WUQ + E_WUQ),
    WD(9, 0, 512, 4096, 0, O_WUKV), WD(9, E_WUKV, 512, 4096, 0, O_WUKV + E_WUKV),
    WD(10, 0, 2048, 2048, 0, O_WOUT_O), WD(10, E_W2K, 2048, 2048, 0, O_WOUT_O + E_W2K),
    WD(11, 0, 2048, DFF, 3, O_WGU), WD(11, (size_t)2048 * DFF, 2048, DFF, 3, O_WGU + E_WGU), WD(11, (size_t)2 * 2048 * DFF, 2048, DFF, 3, O_WGU + 2 * E_WGU), WD(11, (size_t)3 * 2048 * DFF, 2048, DFF, 3, O_WGU + 3 * E_WGU),
    WD(12, 0, 2048, DFF, 4, O_WGU), WD(12, (size_t)2048 * DFF, 2048, DFF, 4, O_WGU + E_WGU), WD(12, (size_t)2 * 2048 * DFF, 2048, DFF, 4, O_WGU + 2 * E_WGU), WD(12, (size_t)3 * 2048 * DFF, 2048, DFF, 4, O_WGU + 3 * E_WGU),
    WD(13, 0, DFF, 2048, 0, O_WDN), WD(13, E_WDN, DFF, 2048, 0, O_WDN + E_WDN), WD(13, 2 * E_WDN, DFF, 2048, 0, O_WDN + 2 * E_WDN), WD(13, 3 * E_WDN, DFF, 2048, 0, O_WDN + 3 * E_WDN)
};
#undef WD

__device__ __forceinline__ void load_wfT(LAS float* wfT, const float* Win  ) {
    for (int idx = pg8::tid_opq(); idx < 16384; idx += 512) { const int k = idx >> 3, h = idx & 7; wfT[h * 2048 + k] = Win[(size_t)k * ABIN + 3072 + h]; }
    __syncthreads();
}
__device__ __forceinline__ void row_phase(int gw, int NGW, int lane, const float* src, bool do_ln, const float* g, const float* b, float* dst_f, bf16r* dst_b,
                                          const LAS float* wfT, const float* fbias, float* logf) {
    for (int m = gw; m < S_; m += NGW) {
        const f32x4* xr = (const f32x4*)(src + (size_t)m * DM) + lane;
        f32x4 v[8];
#pragma unroll
        for (int j = 0; j < 8; ++j) v[j] = xr[64 * j];
        if (do_ln) {
            float s = 0.f;
#pragma unroll
            for (int j = 0; j < 8; ++j) s += (v[j].x + v[j].y) + (v[j].z + v[j].w);
            const float mean = wave_sum(s) * (1.f / DM); float s2 = 0.f;
#pragma unroll
            for (int j = 0; j < 8; ++j) { v[j] = v[j] - mean; s2 += (v[j].x * v[j].x + v[j].y * v[j].y) + (v[j].z * v[j].z + v[j].w * v[j].w); }
            const float rstd = 1.f / sqrtf(wave_sum(s2) * (1.f / DM) + LN_EPS);
#pragma unroll
            for (int j = 0; j < 8; ++j) { const f32x4 gg = *((const f32x4*)g + lane + 64 * j), bb = *((const f32x4*)b + lane + 64 * j); v[j] = v[j] * rstd * gg + bb; }
        }
        if (dst_f) { f32x4* o = (f32x4*)(dst_f + (size_t)m * DM) + lane;
#pragma unroll
            for (int j = 0; j < 8; ++j) o[64 * j] = v[j]; }
        if (dst_b) { unsigned long long* o8 = (unsigned long long*)(dst_b + (size_t)m * DM) + lane;
#pragma unroll
            for (int j = 0; j < 8; ++j) o8[64 * j] = (unsigned long long)pk2(v[j].x, v[j].y) | ((unsigned long long)pk2(v[j].z, v[j].w) << 32); }
        if (logf) {
            float mine = 0.f;
#pragma unroll 1
            for (int h = 0; h < 8; ++h) { float a = 0.f;
#pragma unroll
                for (int j = 0; j < 8; ++j) { const f32x4 w = *((const LAS f32x4*)(wfT + h * 2048) + lane + 64 * j); a += (v[j].x * w.x + v[j].y * w.y) + (v[j].z * w.z + v[j].w * w.w); }
                a = wave_sum(a); if (lane == h) mine = a; }
            if (lane < 8) { const float zf = mine + fbias[lane];
                logf[(size_t)lane * S_ + m] = fminf(zf, 0.f) - log1pf(__expf(-fabsf(zf))); }
        }
    }
}
__device__ __forceinline__ void mla_row_phase(int gw, int NGW, int lane, const bf16r* HM, const float* gq, const float* gkv, const float* cosT, const float* sinT,
                                              bf16r* CQN, bf16r* CKVN, bf16r* KR) {
    float gqv[8], gkvv[8];
#pragma unroll
    for (int e = 0; e < 8; ++e) { gqv[e] = gq[8 * lane + e]; gkvv[e] = gkv[8 * lane + e]; }
    for (int m = gw; m < S_; m += NGW) {
        const bf16r* row = HM + (size_t)m * MLAINP;
        const v4u a = *((const v4u*)row + lane), c = *((const v4u*)(row + 512) + lane);
        float xa[8], xc[8];
#pragma unroll
        for (int e = 0; e < 4; ++e) { xa[2 * e] = __builtin_bit_cast(float, a[e] << 16); xa[2 * e + 1] = __builtin_bit_cast(float, a[e] & 0xffff0000u);
                                      xc[2 * e] = __builtin_bit_cast(float, c[e] << 16); xc[2 * e + 1] = __builtin_bit_cast(float, c[e] & 0xffff0000u); }
        float sa = 0.f, sc2 = 0.f;
#pragma unroll
        for (int e = 0; e < 8; ++e) { sa += xa[e] * xa[e]; sc2 += xc[e] * xc[e]; }
        const float ra = 1.f / sqrtf(wave_sum(sa) * (1.f / 512.f) + RMS_EPS), rc = 1.f / sqrtf(wave_sum(sc2) * (1.f / 512.f) + RMS_EPS);
        v4u oa, oc;
#pragma unroll
        for (int e = 0; e < 4; ++e) { oa[e] = pk2(xa[2 * e] * ra * gqv[2 * e], xa[2 * e + 1] * ra * gqv[2 * e + 1]); oc[e] = pk2(xc[2 * e] * rc * gkvv[2 * e], xc[2 * e + 1] * rc * gkvv[2 * e + 1]); }
        *((v4u*)(CQN + (size_t)m * 512) + lane) = oa; *((v4u*)(CKVN + (size_t)m * 512) + lane) = oc;
        if (lane < 32) { const float x1 = bf2f(row[1024 + lane]), x2 = bf2f(row[1056 + lane]), cc = cosT[(size_t)m * 32 + lane], ss = sinT[(size_t)m * 32 + lane];
            KR[(size_t)m * 64 + lane] = (bf16r)f2bf(x1 * cc - x2 * ss); KR[(size_t)m * 64 + 32 + lane] = (bf16r)f2bf(x1 * ss + x2 * cc); }
    }
}
__device__ __forceinline__ void sincos_d(double r, float& s, float& c) {
    const double x = r * r;
    double ps = 6.446950284384474e-26;
    ps = ps * x - 3.8681701706306835e-23; ps = ps * x + 1.9572941063391263e-20; ps = ps * x - 8.22063524662433e-18; ps = ps * x + 2.8114572543455206e-15;
    ps = ps * x - 7.647163731819816e-13; ps = ps * x + 1.6059043836821613e-10; ps = ps * x - 2.505210838544172e-8; ps = ps * x + 2.7557319223985893e-6;
    ps = ps * x - 1.984126984126984e-4; ps = ps * x + 8.333333333333333e-3; ps = ps * x - 0.16666666666666666; ps = ps * x + 1.0;
    double pc = 1.6117375710961184e-24;
    pc = pc * x - 8.896791392450574e-22; pc = pc * x + 4.110317623312165e-19; pc = pc * x - 1.5619206968586225e-16; pc = pc * x + 4.779477332387385e-14;
    pc = pc * x - 1.1470745597729725e-11; pc = pc * x + 2.08767569878681e-9; pc = pc * x - 2.755731922398589e-7; pc = pc * x + 2.48015873015873e-5;
    pc = pc * x - 1.3888888888888889e-3; pc = pc * x + 4.1666666666666664e-2; pc = pc * x - 0.5; pc = pc * x + 1.0;
    s = (float)(r * ps); c = (float)pc;
}

__device__ __forceinline__ void fox_scan(const float* logf_h, float* cks, float* wsum  ) {
    const int tid = pg8::tid_opq(), lane = tid & 63, wid = tid >> 6;
    float v[16];
#pragma unroll
    for (int q = 0; q < 4; ++q) { const f32x4 t = *(const f32x4*)(logf_h + tid * 16 + q * 4); v[4 * q] = t.x; v[4 * q + 1] = t.y; v[4 * q + 2] = t.z; v[4 * q + 3] = t.w; }
#pragma unroll
    for (int i = 1; i < 16; ++i) v[i] += v[i - 1];
    const float tot = v[15]; float sc = tot;
#pragma unroll
    for (int o = 1; o < 64; o <<= 1) { const float n = __shfl_up(sc, o); if (lane >= o) sc += n; }
    if (lane == 63) wsum[wid] = sc;
    __syncthreads();
    float pre = 0.f;
    for (int w = 0; w < wid; ++w) pre += wsum[w];
    const float excl = pre + sc - tot;
#pragma unroll
    for (int i = 0; i < 16; ++i) cks[tid * 16 + i] = (excl + v[i]) * 11.313708498984761f;
    __syncthreads();
}
__device__ __forceinline__ void moba_gate(const bf16r* Qh  , const float* kpart_h  , const float* rel_bias, int h, int qb0, int qb1,
                                          float* kmean  , float* tab  , unsigned* selb  ) {
    const int tid = pg8::tid_opq();
    for (int i = tid; i < 32 * 128; i += 512) { const int n = i >> 7, d = i & 127; kmean[i] = (kpart_h[(n * 2) * 128 + d] + kpart_h[(n * 2 + 1) * 128 + d]) * (1.f / 256.f); }
    if (tid <= 128) { int bkt; if (tid < 16) bkt = tid; else { bkt = 16 + (int)(log2f((float)tid * (1.f / 16.f)) * (16.f / 3.f)); bkt = bkt > 31 ? 31 : bkt; }
        tab[tid] = rel_bias[bkt * 8 + h] * 11.313708498984761f; }
    __syncthreads();
#pragma unroll 1
    for (int pass = 0; pass < 2; ++pass) {
        const int own = pass ? qb1 : qb0;
        if (tid < 256) {
            const bf16r* qrow = Qh + (size_t)(own * 256 + tid) * 128;
            v4u qv[16];
#pragma unroll
            for (int c = 0; c < 16; ++c) qv[c] = *((const v4u*)qrow + c);
            float v0 = -__builtin_inff(), v1 = v0, v2 = v0; int i0 = -1, i1 = -1, i2 = -1;
#pragma unroll 1
            for (int n = 0; n < own; ++n) {
                const float* km = kmean + n * 128; float g0 = 0.f, g1 = 0.f;
#pragma unroll
                for (int c = 0; c < 16; ++c) { const f32x4 k0 = *(const f32x4*)(km + c * 8), k1 = *(const f32x4*)(km + c * 8 + 4); const v4u q = qv[c];
                    g0 += __builtin_bit_cast(float, q.x << 16) * k0.x + __builtin_bit_cast(float, q.x & 0xffff0000u) * k0.y + __builtin_bit_cast(float, q.y << 16) * k0.z + __builtin_bit_cast(float, q.y & 0xffff0000u) * k0.w;
                    g1 += __builtin_bit_cast(float, q.z << 16) * k1.x + __builtin_bit_cast(float, q.z & 0xffff0000u) * k1.y + __builtin_bit_cast(float, q.w << 16) * k1.z + __builtin_bit_cast(float, q.w & 0xffff0000u) * k1.w; }
                const float g = g0 + g1;
                if (g > v0) { v2 = v1; i2 = i1; v1 = v0; i1 = i0; v0 = g; i0 = n; }
                else if (g > v1) { v2 = v1; i2 = i1; v1 = g; i1 = n; }
                else if (g > v2) { v2 = g; i2 = n; }
            }
            unsigned bits = 1u << own;
            if (i0 >= 0) bits |= 1u << i0; if (i1 >= 0) bits |= 1u << i1; if (i2 >= 0) bits |= 1u << i2;
            selb[pass * 256 + tid] = bits;
        }
    }
    __syncthreads();
}

#define RLX_AGENT __ATOMIC_RELAXED, __HIP_MEMORY_SCOPE_AGENT
#define XB_TMO      128
#define XB_XCNT(j)  (256  + 64 * (j))
#define XB_XSUB(j)  (1280 + 64 * (j))
#define XB_XGEN(j)  (2304 + 64 * (j))
#define XB_TOP      3328
#define XB_TOPGEN   3392
#define XCD_BAR_WORDS 3456
#define XB_SPIN_CAP (1u << 18)

__device__ __forceinline__ unsigned xb_ld(unsigned* p)              { return __hip_atomic_load(p, __ATOMIC_RELAXED, __HIP_MEMORY_SCOPE_AGENT); }
__device__ __forceinline__ unsigned xb_add(unsigned* p, unsigned v) { return __hip_atomic_fetch_add(p, v, __ATOMIC_RELAXED, __HIP_MEMORY_SCOPE_AGENT); }
__device__ __forceinline__ unsigned xb_xcc_id() { return (unsigned)__builtin_amdgcn_s_getreg((3 << 11) | 20) & 0xFu; }
#define XB_SPIN(cond, bar) do { unsigned _sp = 0; while (cond) { __builtin_amdgcn_s_sleep(1); \
    if ((++_sp & 255u) == 0u) { if (xb_ld(&(bar)[XB_TMO])) break; if (_sp > XB_SPIN_CAP) { atomicAdd(&(bar)[XB_TMO], 1u); break; } } } } while (0)

struct XcdBarrier {
    unsigned* bar; unsigned x;
    volatile LAS unsigned* st;
};

__device__ __forceinline__ XcdBarrier xcd_barrier_post(unsigned* bar, volatile LAS unsigned* st) {
    XcdBarrier b; b.bar = bar; b.x = xb_xcc_id(); b.st = st;
    if (threadIdx.x == 0) (void)xb_add(&bar[XB_XCNT(b.x)], 1u);
    return b;
}
__device__ __forceinline__ void xcd_barrier_complete(unsigned* bar, unsigned x, unsigned& nloc, unsigned& nx) {
    const unsigned G = gridDim.x * gridDim.y * gridDim.z;
    unsigned sum, cnt, mine, sp = 0u;
    for (;;) {
        sum = 0u; cnt = 0u; mine = 0u;
#pragma unroll
        for (unsigned j = 0; j < 16; ++j) { const unsigned c = xb_ld(&bar[XB_XCNT(j)]); sum += c; cnt += (c > 0u) ? 1u : 0u; mine = (j == x) ? c : mine; }
        if (sum == G) break;
        __builtin_amdgcn_s_sleep(1);
        if ((++sp & 255u) == 0u) { if (xb_ld(&bar[XB_TMO])) break; if (sp > XB_SPIN_CAP) { atomicAdd(&bar[XB_TMO], 1u); break; } }
    }
    nloc = mine > 0u ? mine : 1u; nx = cnt > 0u ? cnt : 1u;
}

__device__ __forceinline__ void xcd_barrier(const XcdBarrier& b) {
    asm volatile("s_waitcnt vmcnt(0)" ::: "memory");
    __syncthreads();
    if (threadIdx.x == 0) {
        unsigned* bar = b.bar;
        __builtin_amdgcn_s_waitcnt(0);
        unsigned nloc = b.st[0], nx = b.st[1];
        if (nloc == 0u) { xcd_barrier_complete(bar, b.x, nloc, nx); b.st[0] = nloc; b.st[1] = nx; }
        const unsigned old = xb_add(&bar[XB_XSUB(b.x)], 1u);
        const unsigned gen = old / nloc;
        if (old + 1u == (gen + 1u) * nloc) {
            __builtin_amdgcn_fence(__ATOMIC_RELEASE, "agent");
            asm volatile("s_waitcnt vmcnt(0)" ::: "memory");
            const unsigned og = xb_add(&bar[XB_TOP], 1u);
            const unsigned tg = og / nx;
            if (og + 1u == (tg + 1u) * nx) xb_add(&bar[XB_TOPGEN], 1u);
            else XB_SPIN(xb_ld(&bar[XB_TOPGEN]) == tg, bar);
            __builtin_amdgcn_fence(__ATOMIC_ACQUIRE, "agent");
            xb_add(&bar[XB_XGEN(b.x)], 1u);
            asm volatile("s_waitcnt vmcnt(0)" ::: "memory");
        } else {
            XB_SPIN(xb_ld(&bar[XB_XGEN(b.x)]) == gen, bar);
            __builtin_amdgcn_fence(__ATOMIC_ACQUIRE, "agent");
            asm volatile("s_waitcnt vmcnt(0)" ::: "memory");
        }
    }
    __syncthreads();
}

#ifndef PROBE_DUP
#define PROBE_DUP 0
#endif
__global__ void __launch_bounds__(512, 2) mega_fwd(Args args) {
    extern __shared__ __attribute__((aligned(16))) unsigned char lds[];
    cg::grid_group grid = cg::this_grid();
#define ARGIN(k) (args.in[k])
#define PHASE_ENV() \
    int G = gridDim.x, bx = blockIdx.x; asm volatile("" : "+s"(G), "+s"(bx)); const int tid = pg8::tid_opq(), lane = tid & 63, wave = __builtin_amdgcn_readfirstlane(tid >> 6); (void)lane; \
    const int vcu = (G % 8 == 0) ? (bx % 8) * (G / 8) + bx / 8 : bx; const int gw = vcu * 8 + wave, NGW = G * 8; \
    unsigned char* ws = args.ws; asm volatile("" : "+s"(ws)); \
    bf16r* WB = (bf16r*)(ws + WS_W); float* XF = (float*)(ws + WS_XF); bf16r* XB = (bf16r*)(ws + WS_XB); float* Z = (float*)(ws + WS_Z); bf16r* AO = (bf16r*)(ws + WS_AO); \
    unsigned char* ACT = ws + WS_ACT; float* COS = (float*)(ws + WS_COS); float* SIN = (float*)(ws + WS_SIN); float* LOGF = (float*)(ws + WS_LOGF); float* KPART = (float*)(ws + WS_KPART); \
    (void)WB; (void)XF; (void)XB; (void)Z; (void)AO; (void)ACT; (void)COS; (void)SIN; (void)LOGF; (void)KPART; (void)gw; (void)NGW; (void)vcu;
    LAS unsigned char* ldsl = (LAS unsigned char*)lds;
    int ph = 0; constexpr int nph = 1 + 7 + 9 + 7 + 9;
    unsigned* barw = (unsigned*)(args.ws + WS_BAR);
    if (blockIdx.x == 0) for (int i = threadIdx.x; i < XCD_BAR_WORDS; i += 512) barw[i] = 0u;
    if (threadIdx.x < 16) ((LAS unsigned*)(ldsl + LDS_BYTES - 64))[threadIdx.x] = 0u;
    __syncthreads();
    XcdBarrier xbar; xbar.bar = barw; xbar.x = 0; xbar.st = nullptr;
#define PH_ON (true)
#define PH_END do { if (ph == 0) { grid.sync(); xbar = xcd_barrier_post(barw, (volatile LAS unsigned*)(ldsl + LDS_BYTES - 64)); } else if (ph + 1 < nph) { xcd_barrier(xbar); if (PROBE_DUP & 16) { xcd_barrier(xbar); xcd_barrier(xbar); } } ++ph; } while (0)

    if (PH_ON) {
#pragma unroll 1
      for (int rep = 0; rep < ((PROBE_DUP & 1) ? 2 : 1); ++rep) {
        PHASE_ENV();
        LAS float* scr = (LAS float*)(ldsl + wave * 16640);
        int total = 0;
#pragma unroll 1
        for (int d = 0; d < 24; ++d) total += g_wdesc[d].nitems;
#pragma unroll 1
        for (int it = gw; it < total; it += NGW) {
            int r = it, d = 0;
#pragma unroll 1
            while (r >= g_wdesc[d].nitems) { r -= g_wdesc[d].nitems; ++d; }
            const WDesc wd = g_wdesc[d];
            transpose_item(args.in[wd.in_idx] + wd.src_off, wd.K, wd.N, WB + wd.dst_off, wd.mode, scr, r, lane);
        }
        { const int gt = vcu * 512 + tid, NT_ = G * 512; const v4u z4 = (v4u){0u, 0u, 0u, 0u};
          for (int i = gt; i < 2 * 192 * 2048 / 8; i += NT_) { const int j = i / (192 * 2048 / 8), r = i - j * (192 * 2048 / 8);
              *((v4u*)(WB + O_WIN_O + (size_t)j * E_WIN_O + (size_t)MLAIN * 2048) + r) = z4; }
          for (int i = gt; i < S_ * 32; i += NT_) { const int t = i >> 5, k = i & 31;
              const float inv = powf(10000.f, -(float)(2 * k) / 64.f); const float ang = (float)t * inv;
              const double a = (double)ang; const double kk = __builtin_rint(a * 0.15915494309189535); const double rr = __builtin_fma(-kk, 6.283185307179586, a);
              float s, c; sincos_d(rr, s, c); COS[i] = c; SIN[i] = s; } }
        __syncthreads();
        load_wfT((LAS float*)ldsl, ARGIN(1));
        row_phase(gw, NGW, lane, ARGIN(0), false, nullptr, nullptr, nullptr, XB, (const LAS float*)ldsl, ARGIN(2), LOGF);
        __syncthreads();
      }
    }
    PH_END;

#pragma unroll 1
    for (int L = 0; L < 4; ++L) {
        const int odd = L & 1, j = L >> 1, nsteps = odd ? 9 : 7;
#pragma unroll 1
        for (int st = 0; st < nsteps; ++st) {
            int kind, u = -1;
            if (odd) { if (st < 4) kind = st + 1; else u = st - 4; } else { if (st == 0) kind = 0; else if (st == 1) kind = 4; else u = st - 2; }
            if (u >= 0) kind = (u == 0 || u == 3) ? 5 : (u == 2 ? 7 : 6);
            if (PH_ON) {
              const int dupmask = (kind == 4) ? 2 : ((kind == 6 || kind == 2) ? 4 : 8);
#pragma unroll 1
              for (int rep = 0; rep < ((PROBE_DUP & dupmask) ? 2 : 1); ++rep) {
                PHASE_ENV();
                if (kind == 0) {
                    pg8::Gemm g{XB, WB + O_WIN_E + (size_t)j * E_WIN_E, S_, 6144, 2048}; pg8::StaticOrder So; So.init(S_, 6144, G, bx);
                    pg8::EpiHeads E{(bf16r*)ACT, 4, 8, 4, KPART};
                    pg8::gemm_phase<pg8::EpiHeads, pg8::StaticOrder, true, true>(ldsl, g, So, E);
                } else if (kind == 1) {
                    pg8::Gemm g{XB, WB + O_WIN_O + (size_t)j * E_WIN_O, S_, MLAINP, 2048}; pg8::StaticOrder So; So.init(S_, MLAINP, G, bx);
                    pg8::EpiPlain E{(bf16r*)(ACT + A_HM), MLAINP};
                    pg8::gemm_phase<pg8::EpiPlain, pg8::StaticOrder, true, true>(ldsl, g, So, E);
                } else if (kind == 2) {
                    mla_row_phase(gw, NGW, lane, (const bf16r*)(ACT + A_HM), ARGIN(6) + j * 512, ARGIN(7) + j * 512, COS, SIN,
                                  (bf16r*)(ACT + A_CQN), (bf16r*)(ACT + A_CKVN), (bf16r*)(ACT + A_KR));
                } else if (kind == 3) {
                    { pg8::Gemm g{(const bf16r*)(ACT + A_CQN), WB + O_WUQ + (size_t)j * E_WUQ, S_, 3072, 512}; pg8::StaticOrder So; So.init(S_, 3072, G, bx);
                      pg8::EpiQup E{(bf16r*)(ACT + A_QN), (bf16r*)(ACT + A_QR), COS, SIN};
                      pg8::gemm_phase<pg8::EpiQup, pg8::StaticOrder, true, true>(ldsl, g, So, E); }
                    { pg8::Gemm g{(const bf16r*)(ACT + A_CKVN), WB + O_WUKV + (size_t)j * E_WUKV, S_, 4096, 512}; pg8::StaticOrder So; So.init(S_, 4096, G, bx);
                      pg8::EpiKVup E{(bf16r*)(ACT + A_KN), (bf16r*)(ACT + A_V)};
                      pg8::gemm_phase<pg8::EpiKVup, pg8::StaticOrder, true, true>(ldsl, g, So, E); }
                } else if (kind == 4) {
                    using namespace att;
                    char* al = (char*)lds;
#pragma unroll 1
                    for (int item = vcu; item < 256; item += G) {
                        const int h16 = item >> 4, pr = item & 15, qb0 = pr, qb1 = 31 - pr;
                        const size_t HS = (size_t)S_ * 128;
                        Seam Sm;
                        if (odd) {
                            const bf16* QN = (const bf16*)(ACT + A_QN) + h16 * HS; const bf16* QR = (const bf16*)(ACT + A_QR) + (size_t)h16 * S_ * 64;
                            const bf16* KN = (const bf16*)(ACT + A_KN) + h16 * HS; const bf16* VV = (const bf16*)(ACT + A_V) + h16 * HS;
                            bf16* Oh = (bf16*)AO + h16 * 128;
                            Ctx C{(const bf16*)(ACT + A_KR), nullptr, nullptr, 0.f};
                            Ref r0{QN + (size_t)qb0 * 256 * 128, KN, VV, QR + (size_t)qb0 * 256 * 64, Oh + (size_t)qb0 * 256 * OST, qb0 * 256, nullptr};
                            Ref r1{QN + (size_t)qb1 * 256 * 128, KN, VV, QR + (size_t)qb1 * 256 * 64, Oh + (size_t)qb1 * 256 * OST, qb1 * 256, nullptr};
                            att_prime<2>(r0, C, al, Sm); att_block<2>(r0, r1, C, al, Sm); att_block<2>(r1, r1, C, al, Sm);
                        } else if (h16 < 8) {
                            const bf16* Qh = (const bf16*)ACT + (size_t)(0 * 8 + h16) * HS; const bf16* Kh = (const bf16*)ACT + (size_t)(1 * 8 + h16) * HS; const bf16* Vh = (const bf16*)ACT + (size_t)(2 * 8 + h16) * HS;
                            bf16* Oh = (bf16*)AO + h16 * 128;
                            float* cks = (float*)(al + LDS_X);
                            fox_scan(LOGF + (size_t)h16 * S_, cks, (float*)(al + 2 * SHM_V + 2 * SHM_K));
                            Ctx C{nullptr, cks, nullptr, 0.f};
                            Ref r0{Qh + (size_t)qb0 * 256 * 128, Kh, Vh, nullptr, Oh + (size_t)qb0 * 256 * OST, qb0 * 256, nullptr};
                            Ref r1{Qh + (size_t)qb1 * 256 * 128, Kh, Vh, nullptr, Oh + (size_t)qb1 * 256 * OST, qb1 * 256, nullptr};
                            att_prime<0>(r0, C, al, Sm); att_block<0>(r0, r1, C, al, Sm); att_block<0>(r1, r1, C, al, Sm);
                        } else {
                            const int h = h16 - 8;
                            const bf16* Qh = (const bf16*)ACT + (size_t)(3 * 8 + h) * HS; const bf16* Kh = (const bf16*)ACT + (size_t)(4 * 8 + h) * HS; const bf16* Vh = (const bf16*)ACT + (size_t)(5 * 8 + h) * HS;
                            bf16* Oh = (bf16*)AO + h16 * 128;
                            float* kmean = (float*)(al + LDS_X); float* tab = (float*)(al + LDS_TAB); unsigned* selb = (unsigned*)(al + LDS_SEL);
                            moba_gate((const bf16r*)Qh, KPART + (size_t)h * 32 * 2 * 128, ARGIN(4), h, qb0, qb1, kmean, tab, selb);
                            Ctx C{nullptr, nullptr, tab, tab[128]};
                            Ref r0{Qh + (size_t)qb0 * 256 * 128, Kh, Vh, nullptr, Oh + (size_t)qb0 * 256 * OST, qb0 * 256, selb};
                            Ref r1{Qh + (size_t)qb1 * 256 * 128, Kh, Vh, nullptr, Oh + (size_t)qb1 * 256 * OST, qb1 * 256, selb + 256};
                            att_prime<1>(r0, C, al, Sm); att_block<1>(r0, r1, C, al, Sm); att_block<1>(r1, r1, C, al, Sm);
                        }
                        asm volatile("s_waitcnt vmcnt(0)" ::: "memory"); __syncthreads();
                    }
                } else if (kind == 5) {
                    const bool isdown = (u == 3);
                    const bf16r* A = isdown ? (const bf16r*)ACT : AO;
                    const bf16r* Bw = isdown ? WB + O_WDN + (size_t)L * E_WDN : (odd ? WB + O_WOUT_O + (size_t)j * E_W2K : WB + O_WOUT_E + (size_t)j * E_W2K);
                    const float* xres = (!isdown && L == 0) ? ARGIN(0) : XF;
                    pg8::Gemm g{A, Bw, S_, 2048, isdown ? DFF : 2048}; pg8::StaticOrder So; So.init(S_, 2048, G, bx);
                    pg8::EpiResid E{xres, Z, ALPHA};
                    pg8::gemm_phase<pg8::EpiResid, pg8::StaticOrder, true, true>(ldsl, g, So, E);
                } else if (kind == 6) {
                    const int which = (u == 4) ? 1 : 0;
                    const float* gp = ARGIN(14) + (size_t)(L * 2 + which) * DM; const float* bp = ARGIN(15) + (size_t)(L * 2 + which) * DM;
                    const bool last = (L == 3 && which == 1);
                    const bool fg = (which == 1 && L == 1);
                    if (fg) load_wfT((LAS float*)ldsl, ARGIN(1) + (size_t)1 * 2048 * ABIN);
                    row_phase(gw, NGW, lane, Z, true, gp, bp, last ? args.out : XF, last ? nullptr : XB, (const LAS float*)ldsl, ARGIN(2) + 8, fg ? LOGF : nullptr);
                    __syncthreads();
                } else {
                    pg8::Gemm g{XB, WB + O_WGU + (size_t)L * E_WGU, S_, NGU, 2048}; pg8::StaticOrder So; So.init(S_, NGU, G, bx);
                    pg8::EpiSwiglu E{(bf16r*)ACT, DFF};
                    pg8::gemm_phase<pg8::EpiSwiglu, pg8::StaticOrder, true, true>(ldsl, g, So, E);
                }
              }
            }
            PH_END;
        }
    }
#undef PH_ON
#undef PH_END
}

extern "C" void kernel_launch(void* const* d_in, const int* in_sizes, int n_in, void* d_out, int out_size, void* d_ws, size_t ws_size, hipStream_t stream) {
    static int grid = 0;
    if (grid == 0) {
        if (n_in != 16 || out_size != S_ * DM || ws_size < WS_END) { fprintf(stderr, "kernel_launch: unexpected shapes (n_in %d out %d ws %zu need %zu)\n", n_in, out_size, ws_size, (size_t)WS_END); grid = -1; return; }
        int dev = 0, cus = 0, per_cu = 0;
        (void)hipGetDevice(&dev); (void)hipDeviceGetAttribute(&cus, hipDeviceAttributeMultiprocessorCount, dev);
        if (hipFuncSetAttribute((const void*)mega_fwd, hipFuncAttributeMaxDynamicSharedMemorySize, LDS_BYTES) != hipSuccess) fprintf(stderr, "kernel_launch: hipFuncSetAttribute failed\n");
        if (hipOccupancyMaxActiveBlocksPerMultiprocessor(&per_cu, (const void*)mega_fwd, 512, LDS_BYTES) != hipSuccess || per_cu < 1) { fprintf(stderr, "kernel_launch: occupancy query says %d\n", per_cu); per_cu = 1; }
        (void)hipGetLastError();
        if (cus <= 0) cus = 256;
        grid = cus;
    }
    if (grid < 0) return;
    Args a{};
    for (int i = 0; i < 16; ++i) a.in[i] = (const float*)d_in[i];
    a.out = (float*)d_out; a.ws = (unsigned char*)d_ws; a.ph_lo = 0; a.ph_hi = 1000;
    void* params[] = {&a};
    hipError_t e = hipLaunchCooperativeKernel((const void*)mega_fwd, dim3(grid), dim3(512), params, LDS_BYTES, stream);
    if (e != hipSuccess) fprintf(stderr, "kernel_launch: cooperative launch failed: %s (grid %d)\n", hipGetErrorString(e), grid);
}
```
